# Optimizing an MI355X kernel written in HIP

```python
import math
import jax, jax.numpy as jnp
from jax import lax
import numpy as np

D_MODEL = 1024
BATCH = 2
SEQ = 8192
DEPTH = 1

D_MIX = D_MODEL
GLA_HEADS = 4
GLA_DV = D_MIX // 2 // GLA_HEADS
GLA_DK = GLA_DV // 2
GLA_RANK = 16
GLA_GATE_TAU = 16.0
GLA_CHUNK = 64
SWA_HEADS = 8
SWA_KV_HEADS = 2
SWA_HEAD_DIM = D_MIX // 2 // SWA_HEADS
SWA_WINDOW = 128
N_EXPERTS = 32
TOP_K = 4
D_FF = D_MODEL
SWIGLU_LIMIT = 7.0
SWIGLU_ALPHA = 1.702
MOE_BLOCK = 128
NORM_EPS = 1e-5

SPLIT_SIZES = (
    GLA_HEADS * GLA_DK,
    GLA_HEADS * GLA_DK,
    GLA_HEADS * GLA_DV,
    GLA_HEADS * GLA_DV,
    GLA_RANK,
    SWA_HEADS * SWA_HEAD_DIM,
    SWA_KV_HEADS * SWA_HEAD_DIM,
    SWA_KV_HEADS * SWA_HEAD_DIM,
)
D_IN = sum(SPLIT_SIZES)
D_CAT = GLA_HEADS * GLA_DV + SWA_HEADS * SWA_HEAD_DIM

kernel_name = "hymba_gla_swa_sink_moe"


def rmsnorm(x, g):
    xf = x.astype(jnp.float32)
    y = xf * lax.rsqrt(jnp.mean(xf * xf, axis=-1, keepdims=True) + NORM_EPS)
    return (y * g.astype(jnp.float32)).astype(x.dtype)


def alibi_slopes(n):
    return jnp.exp2(-8.0 * jnp.arange(1, n + 1, dtype=jnp.float32) / n)


def gla_chunked(q, k, v, log_a):
    B, L, H, dk = q.shape
    dv = v.shape[-1]
    C = GLA_CHUNK
    n = L // C

    def to_chunks(t):
        return jnp.moveaxis(t.astype(jnp.float32).reshape(B, n, C, H, t.shape[-1]), 1, 0)

    qc, kc, vc, gc = (to_chunks(t) for t in (q * (dk ** -0.5), k, v, log_a))
    causal = jnp.tril(jnp.ones((C, C), dtype=bool))

    def step(S, inp):
        qi, ki, vi, gi = inp
        b = jnp.cumsum(gi, axis=1)
        b_last = b[:, -1]
        q_e = qi * jnp.exp(b)
        k_e = ki * jnp.exp(-b)
        A = jnp.where(causal, jnp.einsum('bihd,bjhd->bhij', q_e, k_e), 0.0)
        o = (jnp.einsum('bhij,bjhv->bihv', A, vi)
             + jnp.einsum('bihd,bhdv->bihv', q_e, S))
        k_tail = ki * jnp.exp(b_last[:, None] - b)
        S = jnp.exp(b_last)[..., None] * S + jnp.einsum('bjhd,bjhv->bhdv', k_tail, vi)
        return S, o

    S0 = jnp.zeros((B, H, dk, dv), jnp.float32)
    _, o = lax.scan(step, S0, (qc, kc, vc, gc))
    return jnp.moveaxis(o, 0, 1).reshape(B, L, H, dv).astype(v.dtype)


def swa_with_sinks(q, k, v, sinks, slopes):
    B, L, Hq, dh = q.shape
    Hkv = k.shape[2]
    G = Hq // Hkv
    W = SWA_WINDOW
    nb = L // W
    qb = q.reshape(B, nb, W, Hkv, G, dh)

    def band(t):
        tb = t.reshape(B, nb, W, Hkv, dh)
        prev = jnp.concatenate([jnp.zeros_like(tb[:, :1]), tb[:, :-1]], axis=1)
        return jnp.concatenate([prev, tb], axis=2)

    kb, vb = band(k), band(v)
    s = jnp.einsum('bnqkgd,bnskd->bnkgqs', qb, kb).astype(jnp.float32) * (dh ** -0.5)
    rel = jnp.arange(W)[:, None] + W - jnp.arange(2 * W)[None, :]
    in_window = (rel >= 0) & (rel < W)
    exists = (jnp.arange(nb)[:, None] > 0) | (jnp.arange(2 * W)[None, :] >= W)
    valid = in_window[None] & exists[:, None, :]
    bias = -slopes.reshape(Hkv, G)[:, :, None, None] * rel.astype(jnp.float32)
    s = jnp.where(valid[None, :, None, None], s + bias, -jnp.inf)
    sink = jnp.broadcast_to(sinks.astype(jnp.float32).reshape(1, 1, Hkv, G, 1, 1),
                            s.shape[:-1] + (1,))
    p = jax.nn.softmax(jnp.concatenate([s, sink], axis=-1), axis=-1)[..., :-1]
    o = jnp.einsum('bnkgqs,bnskd->bnqkgd', p.astype(v.dtype), vb)
    return o.reshape(B, L, Hq * dh)


def moe(h, w_router, b_router, w_glu, b_glu, w_lin, b_lin, w_down, b_down):
    T, D = h.shape
    TK = T * TOP_K
    logits = (h @ w_router + b_router).astype(jnp.float32)
    top_val, top_idx = lax.top_k(logits, TOP_K)
    gate = jax.nn.softmax(top_val, axis=-1)

    flat_e = top_idx.reshape(-1)
    flat_tok = jnp.repeat(jnp.arange(T, dtype=jnp.int32), TOP_K)
    flat_w = gate.reshape(-1)
    order = jnp.argsort(flat_e)
    e_sorted = flat_e[order]
    counts = jnp.bincount(flat_e, length=N_EXPERTS)
    starts = jnp.cumsum(counts) - counts
    padded = (counts + MOE_BLOCK - 1) // MOE_BLOCK * MOE_BLOCK
    pends = jnp.cumsum(padded)
    pstarts = pends - padded
    dest = pstarts[e_sorted] + (jnp.arange(TK) - starts[e_sorted])

    n_blocks = -(-TK // MOE_BLOCK) + N_EXPERTS
    P = n_blocks * MOE_BLOCK
    tok_buf = jnp.zeros((P,), jnp.int32).at[dest].set(flat_tok[order])
    w_buf = jnp.zeros((P,), jnp.float32).at[dest].set(flat_w[order])
    block_expert = jnp.minimum(
        jnp.searchsorted(pends, jnp.arange(n_blocks) * MOE_BLOCK, side='right'), N_EXPERTS - 1)
    xb = h[tok_buf].reshape(n_blocks, MOE_BLOCK, D)

    def expert_block(args):
        xblk, e = args
        glu = jnp.minimum(xblk @ w_glu[e] + b_glu[e], SWIGLU_LIMIT)
        lin = jnp.clip(xblk @ w_lin[e] + b_lin[e], -SWIGLU_LIMIT, SWIGLU_LIMIT)
        hid = glu * jax.nn.sigmoid(SWIGLU_ALPHA * glu) * (lin + 1.0)
        return hid @ w_down[e] + b_down[e]

    y = lax.map(expert_block, (xb, block_expert)).reshape(P, D)
    return jnp.zeros_like(h).at[tok_buf].add(y * w_buf[:, None].astype(h.dtype))


def setup_inputs(seed: int = 0) -> dict:
    key = jax.random.key(seed)
    ks = jax.random.split(key, 20)
    f32 = jnp.float32

    def nrm(k, shape, scale):
        return jax.random.normal(k, shape, f32) * scale

    Ly = DEPTH
    return {
        "x": nrm(ks[0], (BATCH, SEQ, D_MODEL), 1.0),
        "norm1_g": 1.0 + nrm(ks[1], (Ly, D_MODEL), 0.02),
        "w_in": nrm(ks[2], (Ly, D_MODEL, D_IN), D_MODEL ** -0.5),
        "w_alpha_up": nrm(ks[3], (Ly, GLA_RANK, GLA_HEADS * GLA_DK), GLA_RANK ** -0.5),
        "b_alpha": nrm(ks[4], (Ly, GLA_HEADS * GLA_DK), 0.1) + 2.0,
        "gla_norm_g": 1.0 + nrm(ks[5], (Ly, GLA_DV), 0.02),
        "swa_sinks": nrm(ks[6], (Ly, SWA_HEADS), 0.5),
        "swa_norm_g": 1.0 + nrm(ks[7], (Ly, SWA_HEAD_DIM), 0.02),
        "w_out": nrm(ks[8], (Ly, D_CAT, D_MODEL), D_CAT ** -0.5),
        "norm2_g": 1.0 + nrm(ks[9], (Ly, D_MODEL), 0.02),
        "w_router": nrm(ks[10], (Ly, D_MODEL, N_EXPERTS), D_MODEL ** -0.5),
        "b_router": nrm(ks[11], (Ly, N_EXPERTS), 0.01),
        "w_glu": nrm(ks[12], (Ly, N_EXPERTS, D_MODEL, D_FF), D_MODEL ** -0.5),
        "b_glu": nrm(ks[13], (Ly, N_EXPERTS, D_FF), 0.01),
        "w_lin": nrm(ks[14], (Ly, N_EXPERTS, D_MODEL, D_FF), D_MODEL ** -0.5),
        "b_lin": nrm(ks[15], (Ly, N_EXPERTS, D_FF), 0.01),
        "w_down": nrm(ks[16], (Ly, N_EXPERTS, D_FF, D_MODEL), D_FF ** -0.5),
        "b_down": nrm(ks[17], (Ly, N_EXPERTS, D_MODEL), 0.01),
        "final_g": 1.0 + nrm(ks[18], (D_MODEL,), 0.02),
    }


def reference(x, norm1_g, w_in, w_alpha_up, b_alpha, gla_norm_g, swa_sinks, swa_norm_g,
              w_out, norm2_g, w_router, b_router, w_glu, b_glu, w_lin, b_lin,
              w_down, b_down, final_g):
    B, L, D = x.shape
    offsets = [int(o) for o in np.cumsum(SPLIT_SIZES)[:-1]]
    slopes = alibi_slopes(SWA_HEADS)
    h = x
    for l in range(DEPTH):
        u = rmsnorm(h, norm1_g[l])
        proj = u @ w_in[l]
        q_a, k_a, v_a, r_a, z_a, q_b, k_b, v_b = jnp.split(proj, offsets, axis=-1)
        log_a = jax.nn.log_sigmoid(
            (z_a @ w_alpha_up[l] + b_alpha[l]).astype(jnp.float32)) / GLA_GATE_TAU
        o_a = gla_chunked(q_a.reshape(B, L, GLA_HEADS, GLA_DK),
                          k_a.reshape(B, L, GLA_HEADS, GLA_DK),
                          v_a.reshape(B, L, GLA_HEADS, GLA_DV),
                          log_a.reshape(B, L, GLA_HEADS, GLA_DK))
        o_a = rmsnorm(o_a, gla_norm_g[l]).reshape(B, L, GLA_HEADS * GLA_DV) * jax.nn.silu(r_a)
        o_b = swa_with_sinks(q_b.reshape(B, L, SWA_HEADS, SWA_HEAD_DIM),
                             k_b.reshape(B, L, SWA_KV_HEADS, SWA_HEAD_DIM),
                             v_b.reshape(B, L, SWA_KV_HEADS, SWA_HEAD_DIM),
                             swa_sinks[l], slopes)
        o_b = rmsnorm(o_b.reshape(B, L, SWA_HEADS, SWA_HEAD_DIM),
                      swa_norm_g[l]).reshape(B, L, SWA_HEADS * SWA_HEAD_DIM)
        h = h + jnp.concatenate([o_a, o_b], axis=-1) @ w_out[l]
        hn = rmsnorm(h, norm2_g[l]).reshape(B * L, D)
        h = h + moe(hn, w_router[l], b_router[l], w_glu[l], b_glu[l], w_lin[l], b_lin[l],
                    w_down[l], b_down[l]).reshape(B, L, D)
    return rmsnorm(h, final_g)
```

```cpp
#include <hip/hip_runtime.h>
#include <cstdio>
#include <cstdint>

constexpr int BATCH = 2, SEQ = 8192, T = BATCH * SEQ, D = 1024, DIN = 2320;
constexpr int NE = 32, TOPK = 4;
constexpr int C_QA = 0, C_KA = 256, C_VA = 512, C_RA = 1024, C_ZA = 1536, C_QB = 1552, C_KB = 2064, C_VB = 2192;
constexpr float EPS = 1e-5f;
constexpr size_t MiB = 1u << 20;

__device__ __forceinline__ float wave_sum(float v) {
#pragma unroll
    for (int o = 1; o < 64; o <<= 1) v += __shfl_xor(v, o);
    return v;
}
__device__ __forceinline__ float wave_max(float v) {
#pragma unroll
    for (int o = 1; o < 64; o <<= 1) v = fmaxf(v, __shfl_xor(v, o));
    return v;
}
__device__ __forceinline__ float logsigmoidf(float x) { return fminf(x, 0.f) - log1pf(expf(-fabsf(x))); }

__global__ __launch_bounds__(256) void nk_rmsnorm(const float* __restrict__ x, const float* __restrict__ g, float* __restrict__ out) {
    const int row = blockIdx.x * 4 + (threadIdx.x >> 6), lane = threadIdx.x & 63;
    const float* xr = x + (size_t)row * D;
    float v[16]; float s = 0.f;
#pragma unroll
    for (int j = 0; j < 16; ++j) { v[j] = xr[lane + 64 * j]; s += v[j] * v[j]; }
    s = wave_sum(s);
    const float r = rsqrtf(s / D + EPS);
#pragma unroll
    for (int j = 0; j < 16; ++j) out[(size_t)row * D + lane + 64 * j] = v[j] * r * g[lane + 64 * j];
}

template <class ARow>
__device__ __forceinline__ void sgemm_core(float (&acc)[4][4], ARow arow, const float* __restrict__ B, int ldb, int col0, int K, float (*As)[65], float (*Bs)[65]) {
    const int tx = threadIdx.x & 15, ty = threadIdx.x >> 4;
#pragma unroll
    for (int i = 0; i < 4; ++i)
#pragma unroll
        for (int j = 0; j < 4; ++j) acc[i][j] = 0.f;
    for (int k0 = 0; k0 < K; k0 += 16) {
#pragma unroll
        for (int i = 0; i < 4; ++i) { const int e = threadIdx.x + i * 256; const int r = e >> 4, kk = e & 15; As[kk][r] = arow(r)[k0 + kk]; }
#pragma unroll
        for (int i = 0; i < 4; ++i) { const int e = threadIdx.x + i * 256; const int kk = e >> 6, c = e & 63; Bs[kk][c] = (col0 + c < ldb) ? B[(size_t)(k0 + kk) * ldb + col0 + c] : 0.f; }
        __syncthreads();
#pragma unroll
        for (int kk = 0; kk < 16; ++kk) {
            float a[4], b[4];
#pragma unroll
            for (int i = 0; i < 4; ++i) { a[i] = As[kk][ty * 4 + i]; b[i] = Bs[kk][tx * 4 + i]; }
#pragma unroll
            for (int i = 0; i < 4; ++i)
#pragma unroll
                for (int j = 0; j < 4; ++j) acc[i][j] += a[i] * b[j];
        }
        __syncthreads();
    }
}

__global__ __launch_bounds__(256) void nk_gemm(const float* __restrict__ A, const float* __restrict__ B, float* __restrict__ C, const float* __restrict__ add, int N, int K) {
    __shared__ float As[16][65], Bs[16][65];
    const int row0 = blockIdx.y * 64, col0 = blockIdx.x * 64;
    float acc[4][4];
    sgemm_core(acc, [&](int r) { return A + (size_t)(row0 + r) * K; }, B, N, col0, K, As, Bs);
    const int tx = threadIdx.x & 15, ty = threadIdx.x >> 4;
#pragma unroll
    for (int i = 0; i < 4; ++i)
#pragma unroll
        for (int j = 0; j < 4; ++j) { const int r = row0 + ty * 4 + i, c = col0 + tx * 4 + j; if (c < N) C[(size_t)r * N + c] = acc[i][j] + (add ? add[(size_t)r * N + c] : 0.f); }
}

__global__ __launch_bounds__(128) void nk_gla(const float* __restrict__ proj, const float* __restrict__ wup, const float* __restrict__ balpha, float* __restrict__ oa) {
    const int b = blockIdx.x >> 2, h = blockIdx.x & 3, v = threadIdx.x;
    __shared__ float sq[64], sk[64], sa[64];
    float S[64];
#pragma unroll
    for (int d = 0; d < 64; ++d) S[d] = 0.f;
    for (int t = 0; t < SEQ; ++t) {
        const size_t row = (size_t)b * SEQ + t;
        const float* pr = proj + row * DIN;
        if (v < 64) {
            const int col = h * 64 + v;
            float acc = balpha[col];
#pragma unroll
            for (int r = 0; r < 16; ++r) acc += pr[C_ZA + r] * wup[r * 256 + col];
            const float la = logsigmoidf(acc) * (1.f / 16.f);
            sa[v] = expf(la); sq[v] = pr[C_QA + col] * 0.125f; sk[v] = pr[C_KA + col];
        }
        __syncthreads();
        const float vv = pr[C_VA + h * 128 + v];
        float o = 0.f;
#pragma unroll
        for (int d = 0; d < 64; ++d) { S[d] = sa[d] * S[d] + sk[d] * vv; o += sq[d] * S[d]; }
        oa[row * 512 + h * 128 + v] = o;
        __syncthreads();
    }
}
__global__ __launch_bounds__(256) void nk_gla_post(const float* __restrict__ oa, const float* __restrict__ proj, const float* __restrict__ g, float* __restrict__ cat) {
    const int wv = blockIdx.x * 4 + (threadIdx.x >> 6), lane = threadIdx.x & 63;
    const int row = wv >> 2, h = wv & 3;
    const float a0 = oa[(size_t)row * 512 + h * 128 + lane], a1 = oa[(size_t)row * 512 + h * 128 + 64 + lane];
    const float s = wave_sum(a0 * a0 + a1 * a1);
    const float r = rsqrtf(s / 128.f + EPS);
    const float r0 = proj[(size_t)row * DIN + C_RA + h * 128 + lane], r1 = proj[(size_t)row * DIN + C_RA + h * 128 + 64 + lane];
    cat[(size_t)row * D + h * 128 + lane] = a0 * r * g[lane] * (r0 / (1.f + expf(-r0)));
    cat[(size_t)row * D + h * 128 + 64 + lane] = a1 * r * g[64 + lane] * (r1 / (1.f + expf(-r1)));
}
__global__ __launch_bounds__(256) void nk_swa(const float* __restrict__ proj, const float* __restrict__ sinks, const float* __restrict__ g, float* __restrict__ cat) {
    const int wv = blockIdx.x * 4 + (threadIdx.x >> 6), lane = threadIdx.x & 63;
    const int row = wv >> 3, hq = wv & 7, kvh = hq >> 2;
    const int t = row & (SEQ - 1);
    const float slope = exp2f(-(float)(hq + 1));
    const float* q = proj + (size_t)row * DIN + C_QB + hq * 64;
    float sc[2];
#pragma unroll
    for (int i = 0; i < 2; ++i) {
        const int rel = lane + 64 * i;
        if (rel <= t) {
            const float* k = proj + (size_t)(row - rel) * DIN + C_KB + kvh * 64;
            float a = 0.f;
            for (int d = 0; d < 64; ++d) a += q[d] * k[d];
            sc[i] = a * 0.125f - slope * (float)rel;
        } else sc[i] = -INFINITY;
    }
    const float sink = sinks[hq];
    const float m = fmaxf(wave_max(fmaxf(sc[0], sc[1])), sink);
    const float p0 = expf(sc[0] - m), p1 = expf(sc[1] - m);
    const float den = wave_sum(p0 + p1) + expf(sink - m);
    float o = 0.f;
    for (int j = 0; j < 64; ++j) {
        const float pj0 = __shfl(p0, j), pj1 = __shfl(p1, j);
        if (j <= t) o += pj0 * proj[(size_t)(row - j) * DIN + C_VB + kvh * 64 + lane];
        if (j + 64 <= t) o += pj1 * proj[(size_t)(row - j - 64) * DIN + C_VB + kvh * 64 + lane];
    }
    o /= den;
    const float s = wave_sum(o * o);
    cat[(size_t)row * D + 512 + hq * 64 + lane] = o * rsqrtf(s / 64.f + EPS) * g[lane];
}

__global__ __launch_bounds__(256) void nk_router(const float* __restrict__ H, const float* __restrict__ g2, const float* __restrict__ wr, const float* __restrict__ br,
                                                  float* __restrict__ HN, int* __restrict__ cnt, int* __restrict__ tok_list, float* __restrict__ gate_list) {
    const int row = blockIdx.x * 4 + (threadIdx.x >> 6), lane = threadIdx.x & 63;
    const float* hr = H + (size_t)row * D;
    float v[16]; float s = 0.f;
#pragma unroll
    for (int j = 0; j < 16; ++j) { v[j] = hr[lane + 64 * j]; s += v[j] * v[j]; }
    s = wave_sum(s);
    const float r = rsqrtf(s / D + EPS);
#pragma unroll
    for (int j = 0; j < 16; ++j) { v[j] = v[j] * r * g2[lane + 64 * j]; HN[(size_t)row * D + lane + 64 * j] = v[j]; }
    float mylogit = -INFINITY;
    for (int e = 0; e < NE; ++e) {
        float a = 0.f;
#pragma unroll
        for (int j = 0; j < 16; ++j) a += v[j] * wr[(size_t)(lane + 64 * j) * NE + e];
        a = wave_sum(a) + br[e];
        if (lane == e) mylogit = a;
    }
    float tv[4]; int ti[4];
    float cur = mylogit;
#pragma unroll
    for (int k = 0; k < 4; ++k) {
        const float m = wave_max(cur);
        int idx = (cur == m && lane < NE) ? lane : 999;
#pragma unroll
        for (int o = 1; o < 64; o <<= 1) idx = min(idx, __shfl_xor(idx, o));
        tv[k] = m; ti[k] = idx;
        if (lane == idx) cur = -INFINITY;
    }
    const float e0 = 1.f, e1 = expf(tv[1] - tv[0]), e2 = expf(tv[2] - tv[0]), e3 = expf(tv[3] - tv[0]);
    const float inv = 1.f / (e0 + e1 + e2 + e3);
    if (lane < 4) {
        const int e = lane == 0 ? ti[0] : lane == 1 ? ti[1] : lane == 2 ? ti[2] : ti[3];
        const float gt = (lane == 0 ? e0 : lane == 1 ? e1 : lane == 2 ? e2 : e3) * inv;
        const int pos = atomicAdd(&cnt[e], 1);
        tok_list[e * T + pos] = row; gate_list[e * T + pos] = gt;
    }
}

__global__ __launch_bounds__(256) void nk_moe1(const float* __restrict__ HN, const int* __restrict__ cnt, const int* __restrict__ tok_list,
                                                const float* __restrict__ wglu, const float* __restrict__ bglu, const float* __restrict__ wlin, const float* __restrict__ blin, float* __restrict__ hid) {
    __shared__ float As[16][65], Bs[16][65];
    __shared__ int rows[64];
    const int e = blockIdx.z, rt = blockIdx.y, col0 = blockIdx.x * 64;
    const int n = cnt[e];
    if (rt * 64 >= n) return;
    int cstart = 0; for (int i = 0; i < e; ++i) cstart += cnt[i];
    if (threadIdx.x < 64) { const int p = rt * 64 + threadIdx.x; rows[threadIdx.x] = tok_list[e * T + (p < n ? p : 0)]; }
    __syncthreads();
    float ag[4][4], al[4][4];
    sgemm_core(ag, [&](int r) { return HN + (size_t)rows[r] * D; }, wglu + (size_t)e * D * D, D, col0, D, As, Bs);
    sgemm_core(al, [&](int r) { return HN + (size_t)rows[r] * D; }, wlin + (size_t)e * D * D, D, col0, D, As, Bs);
    const int tx = threadIdx.x & 15, ty = threadIdx.x >> 4;
#pragma unroll
    for (int i = 0; i < 4; ++i)
#pragma unroll
        for (int j = 0; j < 4; ++j) {
            const int p = rt * 64 + ty * 4 + i, c = col0 + tx * 4 + j;
            if (p < n) {
                const float glu = fminf(ag[i][j] + bglu[e * D + c], 7.0f);
                const float lin = fminf(fmaxf(al[i][j] + blin[e * D + c], -7.0f), 7.0f);
                hid[(size_t)(cstart + p) * D + c] = glu / (1.f + expf(-1.702f * glu)) * (lin + 1.f);
            }
        }
}
__global__ __launch_bounds__(256) void nk_moe2(const float* __restrict__ hid, const int* __restrict__ cnt, const int* __restrict__ tok_list, const float* __restrict__ gate_list,
                                                const float* __restrict__ wdown, const float* __restrict__ bdown, float* __restrict__ accout) {
    __shared__ float As[16][65], Bs[16][65];
    const int e = blockIdx.z, rt = blockIdx.y, col0 = blockIdx.x * 64;
    const int n = cnt[e];
    if (rt * 64 >= n) return;
    int cstart = 0; for (int i = 0; i < e; ++i) cstart += cnt[i];
    float acc[4][4];
    sgemm_core(acc, [&](int r) { const int p = rt * 64 + r; return hid + (size_t)(cstart + (p < n ? p : 0)) * D; }, wdown + (size_t)e * D * D, D, col0, D, As, Bs);
    const int tx = threadIdx.x & 15, ty = threadIdx.x >> 4;
#pragma unroll
    for (int i = 0; i < 4; ++i) {
        const int p = rt * 64 + ty * 4 + i;
        if (p < n) {
            const int tok = tok_list[e * T + p]; const float gt = gate_list[e * T + p];
#pragma unroll
            for (int j = 0; j < 4; ++j) { const int c = col0 + tx * 4 + j; atomicAdd(&accout[(size_t)tok * D + c], gt * (acc[i][j] + bdown[e * D + c])); }
        }
    }
}
__global__ __launch_bounds__(256) void nk_final(const float* __restrict__ H, const float* __restrict__ g, float* __restrict__ out) {
    const int row = blockIdx.x * 4 + (threadIdx.x >> 6), lane = threadIdx.x & 63;
    float v[16]; float s = 0.f;
#pragma unroll
    for (int j = 0; j < 16; ++j) { v[j] = H[(size_t)row * D + lane + 64 * j] + out[(size_t)row * D + lane + 64 * j]; s += v[j] * v[j]; }
    s = wave_sum(s);
    const float r = rsqrtf(s / D + EPS);
#pragma unroll
    for (int j = 0; j < 16; ++j) out[(size_t)row * D + lane + 64 * j] = v[j] * r * g[lane + 64 * j];
}

extern "C" void kernel_launch(void* const* d_in, const int* in_sizes, int n_in, void* d_out, int out_size, void* d_ws, size_t ws_size, hipStream_t stream) {
    const float* x = (const float*)d_in[0]; const float* norm1_g = (const float*)d_in[1]; const float* w_in = (const float*)d_in[2];
    const float* w_alpha_up = (const float*)d_in[3]; const float* b_alpha = (const float*)d_in[4]; const float* gla_norm_g = (const float*)d_in[5];
    const float* swa_sinks = (const float*)d_in[6]; const float* swa_norm_g = (const float*)d_in[7]; const float* w_out = (const float*)d_in[8];
    const float* norm2_g = (const float*)d_in[9]; const float* w_router = (const float*)d_in[10]; const float* b_router = (const float*)d_in[11];
    const float* w_glu = (const float*)d_in[12]; const float* b_glu = (const float*)d_in[13]; const float* w_lin = (const float*)d_in[14]; const float* b_lin = (const float*)d_in[15];
    const float* w_down = (const float*)d_in[16]; const float* b_down = (const float*)d_in[17]; const float* final_g = (const float*)d_in[18];
    float* out = (float*)d_out;
    char* ws = (char*)d_ws;
    if (ws_size < 452 * MiB) { fprintf(stderr, "ws too small: %zu\n", ws_size); return; }
    int* cnt = (int*)(ws + 0);
    int* tok_list = (int*)(ws + 1 * MiB);
    float* gate_list = (float*)(ws + 3 * MiB);
    float* U = (float*)(ws + 16 * MiB);
    float* PROJ = (float*)(ws + 80 * MiB);
    float* OA = (float*)(ws + 226 * MiB);
    float* CAT = (float*)(ws + 258 * MiB);
    float* HID = (float*)(ws + 16 * MiB);
    float* H = (float*)(ws + 322 * MiB);
    float* HN = (float*)(ws + 386 * MiB);
    hipMemsetAsync(cnt, 0, 256, stream);
    hipMemsetAsync(out, 0, (size_t)T * D * 4, stream);
    nk_rmsnorm<<<T / 4, 256, 0, stream>>>(x, norm1_g, U);
    nk_gemm<<<dim3((DIN + 63) / 64, T / 64), 256, 0, stream>>>(U, w_in, PROJ, nullptr, DIN, D);
    nk_gla<<<8, 128, 0, stream>>>(PROJ, w_alpha_up, b_alpha, OA);
    nk_gla_post<<<T * 4 / 4, 256, 0, stream>>>(OA, PROJ, gla_norm_g, CAT);
    nk_swa<<<T * 8 / 4, 256, 0, stream>>>(PROJ, swa_sinks, swa_norm_g, CAT);
    nk_gemm<<<dim3(D / 64, T / 64), 256, 0, stream>>>(CAT, w_out, H, x, D, D);
    nk_router<<<T / 4, 256, 0, stream>>>(H, norm2_g, w_router, b_router, HN, cnt, tok_list, gate_list);
    nk_moe1<<<dim3(D / 64, T / 64, NE), 256, 0, stream>>>(HN, cnt, tok_list, w_glu, b_glu, w_lin, b_lin, HID);
    nk_moe2<<<dim3(D / 64, T / 64, NE), 256, 0, stream>>>(HID, cnt, tok_list, gate_list, w_down, b_down, out);
    nk_final<<<T / 4, 256, 0, stream>>>(H, final_g, out);
}
```

```cpp
#include <hip/hip_runtime.h>
#include <cstdio>
#include <cstdint>

constexpr int BATCH = 2, SEQ = 8192, T = BATCH * SEQ, D = 1024, DIN = 2320, DINP = 2560;
constexpr int NE = 32, TOPK = 4;
constexpr int C_QA = 0, C_KA = 256, C_VA = 512, C_RA = 1024, C_ZA = 1536, C_QB = 1552, C_KB = 2064, C_VB = 2192;
constexpr float EPS = 1e-5f;
constexpr int PMAX = 73728;
constexpr size_t MiB = 1u << 20;
constexpr size_t WS_CTL = 0, CTL_ZERO_BYTES = 1 * MiB;
constexpr size_t WS_TOKL = 1 * MiB;
constexpr size_t WS_SEL = 3 * MiB;
constexpr size_t WS_RSTD = 3 * MiB + 768 * 1024;
constexpr size_t WS_WRH = 11 * MiB, WS_WRL = 11 * MiB + 65536;
constexpr size_t WS_WIN = 4 * MiB;
constexpr size_t WS_WOUT = 9 * MiB;
constexpr size_t WS_WD = 16 * MiB;
constexpr size_t WS_WGL = 80 * MiB;
constexpr size_t WS_HN = 208 * MiB;
constexpr size_t WS_PROJ = 240 * MiB;
constexpr size_t WS_XN = 320 * MiB;
constexpr size_t WS_CAT = 352 * MiB;
constexpr size_t WS_ATT = 320 * MiB;
constexpr size_t WS_HID = 240 * MiB;
constexpr size_t WS_Y = 80 * MiB;
constexpr size_t WS_KV = 384 * MiB;
constexpr size_t WS_SPREV = 416 * MiB;
constexpr size_t WS_DECAY = 432 * MiB;
constexpr size_t WS_BLG = 440 * MiB;
constexpr size_t WS_END = 456 * MiB;
constexpr int CW_CNT = 0, CNT_STRIDE = 32;
constexpr int CW_BAR = 4096;

#ifndef MOE_FP8
#define MOE_FP8 1
#endif
#ifndef Y_FP8
#define Y_FP8 1
#endif
constexpr float FP8_SW = 64.f, FP8_SA = 8.f, FP8_SH = 4.f, FP8_SY = 16.f;
static_assert(MOE_FP8, "the workspace map assumes fp8 HID (72 MiB)");
typedef unsigned short bf16;
__device__ __forceinline__ float bf2f(bf16 v) { return __builtin_bit_cast(float, (unsigned)v << 16); }
typedef float f32x2_t __attribute__((ext_vector_type(2))); typedef __bf16 bf16x2_t __attribute__((ext_vector_type(2)));
__device__ __forceinline__ unsigned pk2(float lo, float hi) { const f32x2_t v = {lo, hi}; const bf16x2_t b = __builtin_convertvector(v, bf16x2_t); return __builtin_bit_cast(unsigned, b); }
__device__ __forceinline__ unsigned f2bf(float f) { return pk2(f, 0.f) & 0xffffu; }
__device__ __forceinline__ float ldf(const float* p) { return *p; }
__device__ __forceinline__ float ldf(const bf16* p) { return bf2f(*p); }

__device__ __forceinline__ float wave_sum(float v) {
#pragma unroll
    for (int o = 1; o < 64; o <<= 1) v += __shfl_xor(v, o);
    return v;
}
__device__ __forceinline__ float wave_max(float v) {
#pragma unroll
    for (int o = 1; o < 64; o <<= 1) v = fmaxf(v, __shfl_xor(v, o));
    return v;
}
__device__ __forceinline__ float logsigmoidf(float x) { return fminf(x, 0.f) - log1pf(expf(-fabsf(x))); }
__device__ __forceinline__ float logsigmoid_fast(float x) { return fminf(x, 0.f) - __logf(1.f + __expf(-fabsf(x))); }
namespace pg8 {
#define PG8_LAS __attribute__((address_space(3)))
typedef unsigned short bf16_t;
typedef short bf16x8 __attribute__((ext_vector_type(8)));
typedef float f32x4 __attribute__((ext_vector_type(4)));
typedef unsigned u32x4 __attribute__((ext_vector_type(4)));
constexpr int BM = 256, BK = 64, HALF = 128, HTB = HALF * BK * 2  , STAGE_BYTES = 8 * HTB;

__host__ __device__ __forceinline__ int lds_byte(int r, int c) { const int st = (r >> 4) * 2 + (c >> 5), rr = r & 15, cc = c & 31, ob = rr * 64 + cc * 2; return st * 1024 + (ob ^ (((ob >> 9) & 1) << 5)); }
__host__ __device__ __forceinline__ void stage_rc(int b, int& R, int& C) { const int st = b / 1024, sb = b % 1024, swz = sb ^ (((sb >> 9) & 1) << 5); R = (st >> 1) * 16 + swz / 64; C = (st & 1) * 32 + (swz % 64) / 2; }
__host__ __device__ __forceinline__ int perm32(int rho) { const int n = rho >> 4, i = rho & 15; return 8 * (i >> 2) + 4 * n + (i & 3); }

struct Unit { int pm, pn, am, bn, e, ui, skip, kind; };
struct Gemm { const bf16_t* A; const bf16_t* Bt; int K; };

typedef int v8i32 __attribute__((ext_vector_type(8)));
__device__ __forceinline__ v8i32 cat8(bf16x8 lo, bf16x8 hi) { const u32x4 a = __builtin_bit_cast(u32x4, lo), b = __builtin_bit_cast(u32x4, hi); return (v8i32){(int)a.x, (int)a.y, (int)a.z, (int)a.w, (int)b.x, (int)b.y, (int)b.z, (int)b.w}; }
__device__ __forceinline__ unsigned cvt_pk_bf16(float lo, float hi) { unsigned r; asm volatile("v_cvt_pk_bf16_f32 %0, %1, %2" : "=v"(r) : "v"(lo), "v"(hi)); return r; }

template <class Epi, class Sched, bool ALIGN_EPI, bool GATHER, bool FP8 = false, bool HOOKS = false>
__device__ __forceinline__ void gemm_phase(PG8_LAS unsigned char* lds, const Gemm g, const Sched& S, const Epi& E) {
    const int tid = threadIdx.x, wid = __builtin_amdgcn_readfirstlane(tid >> 6), lane = tid & 63, wr = wid >> 2, wc = wid & 3, fr = lane & 15, fq = lane >> 4;
    int K = g.K; asm volatile("" : "+s"(K));
    const int nt = K / BK;
    const size_t kstep = (size_t)(BK * 2);
    const size_t hstep = (size_t)HALF * K * 2;
    const size_t tstep = 2 * hstep;
    unsigned voffA0[2], voffA1[2], voffB[2];
#pragma unroll
    for (int i = 0; i < 2; ++i) { int R, C; stage_rc(tid * 16 + i * 8192, R, C); const int Rb = Epi::PERM ? ((R & ~31) + perm32(R & 31)) : R;
        voffA0[i] = (unsigned)(R * K + C) * 2u; voffA1[i] = voffA0[i] + (unsigned)hstep; voffB[i] = (unsigned)(Rb * K + C) * 2u; }
    const unsigned ldsw = (unsigned)wid * 1024u;
    const int aoff = lds_byte(wr * 64 + fr, fq * 8), boff = lds_byte(wc * 32 + fr, fq * 8);
#define PG8_SA(b, h) (((b) * 2 + (h)) * HTB)
#define PG8_SB(b, h) ((4 + (b) * 2 + (h)) * HTB)
#define PG8_STAGE(bufoff, gbase, voff) do { _Pragma("unroll") for (int _i = 0; _i < 2; ++_i) \
        __builtin_amdgcn_global_load_lds((const unsigned*)((const char*)(gbase) + (voff)[_i]), (PG8_LAS unsigned*)(lds + (bufoff) + ldsw + _i * 8192), 16, 0, 0); } while (0)
#define PG8_LDA(dst, b, h) do { _Pragma("unroll") for (int m = 0; m < 4; ++m) { if constexpr (FP8) { dst##8[m] = cat8(*(const PG8_LAS bf16x8*)(lds + PG8_SA(b, h) + aoff + m * 2048), *(const PG8_LAS bf16x8*)(lds + PG8_SA(b, h) + aoff + m * 2048 + 1024)); } \
        else { _Pragma("unroll") for (int k = 0; k < 2; ++k) dst[m][k] = *(const PG8_LAS bf16x8*)(lds + PG8_SA(b, h) + aoff + m * 2048 + k * 1024); } } } while (0)
#define PG8_LDB(dst, b, h) do { _Pragma("unroll") for (int n = 0; n < 2; ++n) { if constexpr (FP8) { dst##8[n] = cat8(*(const PG8_LAS bf16x8*)(lds + PG8_SB(b, h) + boff + n * 2048), *(const PG8_LAS bf16x8*)(lds + PG8_SB(b, h) + boff + n * 2048 + 1024)); } \
        else { _Pragma("unroll") for (int k = 0; k < 2; ++k) dst[n][k] = *(const PG8_LAS bf16x8*)(lds + PG8_SB(b, h) + boff + n * 2048 + k * 1024); } } } while (0)
#define PG8_MMA(ai, bj, At, Bt) do { __builtin_amdgcn_s_setprio(1); _Pragma("unroll") for (int m = 0; m < 4; ++m) _Pragma("unroll") for (int n = 0; n < 2; ++n) { \
        if constexpr (FP8) { acc[ai][bj][m][n] = __builtin_amdgcn_mfma_scale_f32_16x16x128_f8f6f4(Bt##8[n], At##8[m], acc[ai][bj][m][n], 0, 0, 0, 0x7f7f7f7f, 0, 0x7f7f7f7f); } \
        else { _Pragma("unroll") for (int k = 0; k < 2; ++k) acc[ai][bj][m][n] = __builtin_amdgcn_mfma_f32_16x16x32_bf16(Bt[n][k], At[m][k], acc[ai][bj][m][n], 0, 0, 0); } } \
        __builtin_amdgcn_s_setprio(0); } while (0)
#define PG8_WAIT_V(n) asm volatile("s_waitcnt vmcnt(" #n ")" ::: "memory")
#define PG8_WAIT_L(n) asm volatile("s_waitcnt lgkmcnt(" #n ")" ::: "memory")
#define PG8_BAR __builtin_amdgcn_s_barrier()
#define PG8_SCHED __builtin_amdgcn_sched_barrier(0)
#define PG8_GROWS(tab) do { _Pragma("unroll") for (int _i = 0; _i < 2; ++_i) { int R_, C_; stage_rc(tid * 16 + _i * 8192, R_, C_); \
        voffA0[_i] = (unsigned)((tab)[R_] * K + C_) * 2u; voffA1[_i] = (unsigned)((tab)[HALF + R_] * K + C_) * 2u; } } while (0)
    Unit cur, nxt; int ui = 0;
    if (!S.next(0, cur)) return;
    if constexpr (HOOKS) S.a_ready(cur);
    if constexpr (GATHER) { PG8_GROWS(S.rows(0)); }
    f32x4 acc[2][2][4][2];
#pragma unroll
    for (int a = 0; a < 2; ++a)
#pragma unroll
        for (int b = 0; b < 2; ++b)
#pragma unroll
            for (int m = 0; m < 4; ++m)
#pragma unroll
                for (int n = 0; n < 2; ++n) acc[a][b][m][n] = (f32x4){0.f, 0.f, 0.f, 0.f};
    bf16x8 At[4][2], B0[2][2], B1[2][2];
    v8i32 At8[4], B08[2], B18[2];
    const char* cA = HOOKS ? S.abase(cur) : (GATHER ? (const char*)g.A : (const char*)g.A + (size_t)cur.am * tstep); const char* cB = HOOKS ? S.bbase(cur, tstep) : (const char*)g.Bt + (size_t)cur.bn * tstep;
    PG8_STAGE(PG8_SB(0, 0), cB, voffB); PG8_STAGE(PG8_SB(0, 1), cB + hstep, voffB); PG8_STAGE(PG8_SA(0, 0), cA, voffA0); PG8_STAGE(PG8_SA(0, 1), cA, voffA1);
    if (wr == 1) PG8_BAR;
    PG8_WAIT_V(2); PG8_BAR;
    PG8_STAGE(PG8_SB(1, 0), cB + kstep, voffB); PG8_STAGE(PG8_SA(1, 0), cA + kstep, voffA0); PG8_STAGE(PG8_SB(1, 1), cB + hstep + kstep, voffB);
    PG8_WAIT_V(6); PG8_BAR;
    for (;;) {
        const bool has_next = S.next(ui + 1, nxt);
        const char* nA = HOOKS ? (has_next ? S.abase(nxt) : cA) : (GATHER ? (const char*)g.A : (has_next ? (const char*)g.A + (size_t)nxt.am * tstep : cA));
        const char* nB = has_next ? (HOOKS ? S.bbase(nxt, tstep) : (const char*)g.Bt + (size_t)nxt.bn * tstep) : cB;
#pragma unroll 1
        for (int t = 0; t < nt; t += 2) {
            const bool last = (t == nt - 2);
            const char* a1 = cA + (size_t)(t + 1) * kstep;
            const char* a2 = last ? nA : cA + (size_t)(t + 2) * kstep; const char* b2 = last ? nB : cB + (size_t)(t + 2) * kstep;
            const char* a3 = a2 + kstep; const char* b3 = b2 + kstep;
            if constexpr (HOOKS) { if (last && has_next) S.a_ready(nxt); }
            PG8_LDB(B0, 0, 0); PG8_LDB(B1, 0, 1); PG8_SCHED; PG8_LDA(At, 0, 0); PG8_STAGE(PG8_SA(1, 1), a1, voffA1);
            if constexpr (GATHER) { if (last && has_next) { PG8_GROWS(S.rows(ui + 1)); } }
            PG8_WAIT_V(8); PG8_WAIT_L(0); PG8_BAR; PG8_MMA(0, 0, At, B0); PG8_MMA(0, 1, At, B1); PG8_BAR; PG8_SCHED;
            PG8_LDA(At, 0, 1); PG8_STAGE(PG8_SB(0, 0), b2, voffB); PG8_STAGE(PG8_SB(0, 1), b2 + hstep, voffB); PG8_STAGE(PG8_SA(0, 0), a2, voffA0);
            PG8_WAIT_V(8); PG8_WAIT_L(0); PG8_BAR; PG8_MMA(1, 0, At, B0); PG8_MMA(1, 1, At, B1); PG8_BAR; PG8_SCHED;
            PG8_LDB(B0, 1, 0); PG8_LDB(B1, 1, 1); PG8_SCHED; PG8_LDA(At, 1, 0); PG8_STAGE(PG8_SA(0, 1), a2, voffA1);
            PG8_WAIT_V(8); PG8_WAIT_L(0); PG8_BAR; PG8_MMA(0, 0, At, B0); PG8_MMA(0, 1, At, B1); PG8_BAR; PG8_SCHED;
            PG8_LDA(At, 1, 1); PG8_STAGE(PG8_SB(1, 0), b3, voffB); PG8_STAGE(PG8_SB(1, 1), b3 + hstep, voffB); PG8_STAGE(PG8_SA(1, 0), a3, voffA0);
            PG8_WAIT_V(8); PG8_WAIT_L(0); PG8_BAR; PG8_MMA(1, 0, At, B0); PG8_MMA(1, 1, At, B1); PG8_BAR; PG8_SCHED;
        }
        if constexpr (ALIGN_EPI) { if (wr == 0) PG8_BAR; }
        E(acc, cur, wr, wc, fr, fq);
        if constexpr (HOOKS) S.done(cur);
        if (!has_next) break;
#pragma unroll
        for (int a = 0; a < 2; ++a)
#pragma unroll
            for (int b = 0; b < 2; ++b)
#pragma unroll
                for (int m = 0; m < 4; ++m)
#pragma unroll
                    for (int n = 0; n < 2; ++n) acc[a][b][m][n] = (f32x4){0.f, 0.f, 0.f, 0.f};
        cur = nxt; cA = nA; cB = nB; ++ui;
        if constexpr (ALIGN_EPI) { if (wr == 1) PG8_BAR; }
    }
    PG8_WAIT_V(0);
    if constexpr (!ALIGN_EPI) { if (wr == 0) PG8_BAR; }
    PG8_BAR;
#undef PG8_SA
#undef PG8_SB
#undef PG8_STAGE
#undef PG8_LDA
#undef PG8_LDB
#undef PG8_MMA
#undef PG8_WAIT_V
#undef PG8_WAIT_L
#undef PG8_BAR
#undef PG8_SCHED
#undef PG8_GROWS
}

__device__ __forceinline__ float clamp448(float v) { return fminf(fmaxf(v, -448.f), 448.f); }
__device__ __forceinline__ unsigned pack4_fp8(float a, float b, float c, float d) {
    int w = __builtin_amdgcn_cvt_pk_fp8_f32(clamp448(a), clamp448(b), 0, false); w = __builtin_amdgcn_cvt_pk_fp8_f32(clamp448(c), clamp448(d), w, true); return (unsigned)w; }
template <int MODE> struct EpiOut {
    static constexpr bool PERM = true;
    bf16_t* O; int ldc; const float* bias; int bstride; float ascale; float oscale;
    __device__ __forceinline__ void operator()(const f32x4 (&acc)[2][2][4][2], const Unit& u, int wr, int wc, int fr, int fq) const {
        const int row0 = u.pm * BM + wr * 64 + fr, col0 = u.pn * BM + wc * 32 + 8 * fq;
        f32x4 bv[2][2]; const float sc = ascale * oscale;
        if constexpr (MODE == 1) {
#pragma unroll
            for (int bj = 0; bj < 2; ++bj)
#pragma unroll
                for (int n = 0; n < 2; ++n) bv[bj][n] = *(const f32x4*)(bias + (size_t)u.e * bstride + col0 + bj * HALF + 4 * n) * oscale;
        }
#pragma unroll
        for (int ai = 0; ai < 2; ++ai)
#pragma unroll
            for (int m = 0; m < 4; ++m) {
#pragma unroll
                for (int bj = 0; bj < 2; ++bj) {
                    if constexpr (MODE == 1) { const f32x4 v0 = acc[ai][bj][m][0] * sc + bv[bj][0], v1 = acc[ai][bj][m][1] * sc + bv[bj][1];
                        typedef unsigned u32x2 __attribute__((ext_vector_type(2))); u32x2 w8; w8.x = pack4_fp8(v0[0], v0[1], v0[2], v0[3]); w8.y = pack4_fp8(v1[0], v1[1], v1[2], v1[3]);
                        *(u32x2*)((unsigned char*)O + (size_t)(row0 + ai * HALF + m * 16) * ldc + col0 + bj * HALF) = w8; }
                    else { const f32x4 v0 = acc[ai][bj][m][0], v1 = acc[ai][bj][m][1];
                        u32x4 w; w.x = cvt_pk_bf16(v0[0], v0[1]); w.y = cvt_pk_bf16(v0[2], v0[3]); w.z = cvt_pk_bf16(v1[0], v1[1]); w.w = cvt_pk_bf16(v1[2], v1[3]);
                        *(u32x4*)(O + (size_t)(row0 + ai * HALF + m * 16) * ldc + col0 + bj * HALF) = w; } } }
    }
};
struct EpiResF32 {
    static constexpr bool PERM = false;
    const float* res; float* out; int ldc;
    __device__ __forceinline__ void operator()(const f32x4 (&acc)[2][2][4][2], const Unit& u, int wr, int wc, int fr, int fq) const {
        const int row0 = u.pm * BM + wr * 64 + fr, col0 = u.pn * BM + wc * 32 + 4 * fq;
#pragma unroll
        for (int ai = 0; ai < 2; ++ai)
#pragma unroll
            for (int m = 0; m < 4; ++m) { const size_t off = (size_t)(row0 + ai * HALF + m * 16) * ldc + col0;
#pragma unroll
                for (int bj = 0; bj < 2; ++bj)
#pragma unroll
                    for (int n = 0; n < 2; ++n) { const f32x4 r = *(const f32x4*)(res + off + bj * HALF + n * 16); *(f32x4*)(out + off + bj * HALF + n * 16) = r + acc[ai][bj][m][n]; } }
    }
};
struct EpiSwiglu {
    static constexpr bool PERM = true;
    bf16_t* O; const float* bglu; const float* blin; const PG8_LAS float* rstdtab;
    float ascale; int out8; float oscale;
    int wt_tiles;
    typedef float f32x2 __attribute__((ext_vector_type(2)));
    __device__ __forceinline__ static f32x2 act2(f32x2 g, f32x2 l, float osc) {
        g = __builtin_elementwise_min(g, (f32x2){7.0f, 7.0f});
        l.x = __builtin_amdgcn_fmed3f(l.x, -7.0f, 7.0f); l.y = __builtin_amdgcn_fmed3f(l.y, -7.0f, 7.0f);
        const f32x2 t = g * -2.4554669596f;
        f32x2 e; e.x = __builtin_amdgcn_exp2f(t.x); e.y = __builtin_amdgcn_exp2f(t.y);
        e = e + 1.0f;
        f32x2 r; r.x = __builtin_amdgcn_rcpf(e.x); r.y = __builtin_amdgcn_rcpf(e.y);
        return (g * r) * (l * osc + osc);
    }
    __device__ __forceinline__ void operator()(const f32x4 (&acc)[2][2][4][2], const Unit& u, int wr, int wc, int fr, int fq) const {
        const int row0 = u.pm * BM + wr * 64 + fr, col0 = u.pn * HALF + wc * 32 + 8 * fq;
        f32x4 bg[2], bl[2];
#pragma unroll
        for (int n = 0; n < 2; ++n) { bg[n] = *(const f32x4*)(bglu + (size_t)u.e * 1024 + col0 + 4 * n); bl[n] = *(const f32x4*)(blin + (size_t)u.e * 1024 + col0 + 4 * n); }
        const float osc = out8 ? oscale : 1.0f; const bool wt = u.pm < wt_tiles;
#pragma unroll
        for (int ai = 0; ai < 2; ++ai)
#pragma unroll
            for (int m = 0; m < 4; ++m) {
                const float rs = rstdtab[u.ui * 256 + ai * HALF + wr * 64 + m * 16 + fr] * ascale;
                float h[8];
#pragma unroll
                for (int n = 0; n < 2; ++n) { const f32x4 gv = acc[ai][0][m][n] * rs + bg[n], lv = acc[ai][1][m][n] * rs + bl[n];
                    const f32x2 h0 = act2((f32x2){gv[0], gv[1]}, (f32x2){lv[0], lv[1]}, osc), h1 = act2((f32x2){gv[2], gv[3]}, (f32x2){lv[2], lv[3]}, osc);
                    h[4 * n] = h0.x; h[4 * n + 1] = h0.y; h[4 * n + 2] = h1.x; h[4 * n + 3] = h1.y; }
                if (out8) { typedef unsigned u32x2 __attribute__((ext_vector_type(2))); u32x2 w8;
                    int w0 = __builtin_amdgcn_cvt_pk_fp8_f32(h[0], h[1], 0, false); w0 = __builtin_amdgcn_cvt_pk_fp8_f32(h[2], h[3], w0, true);
                    int w1 = __builtin_amdgcn_cvt_pk_fp8_f32(h[4], h[5], 0, false); w1 = __builtin_amdgcn_cvt_pk_fp8_f32(h[6], h[7], w1, true);
                    w8.x = (unsigned)w0; w8.y = (unsigned)w1;
                    unsigned char* dp = (unsigned char*)O + (size_t)(row0 + ai * HALF + m * 16) * 1024 + col0;
                    if (wt) __hip_atomic_store((unsigned long long*)dp, ((unsigned long long)w8.y << 32) | w8.x, __ATOMIC_RELAXED, __HIP_MEMORY_SCOPE_AGENT); else *(u32x2*)dp = w8; }
                else { u32x4 w; w.x = cvt_pk_bf16(h[0], h[1]); w.y = cvt_pk_bf16(h[2], h[3]); w.z = cvt_pk_bf16(h[4], h[5]); w.w = cvt_pk_bf16(h[6], h[7]);
                    *(u32x4*)(O + (size_t)(row0 + ai * HALF + m * 16) * 1024 + col0) = w; } }
    }
};
}
#define GAS __attribute__((address_space(1)))
#define LAS __attribute__((address_space(3)))
typedef unsigned v4u __attribute__((ext_vector_type(4)));
typedef float f32x4 __attribute__((ext_vector_type(4)));
typedef short bf16x8 __attribute__((ext_vector_type(8)));
typedef GAS unsigned gu32;
typedef GAS unsigned long long gu64;
#define RLX_AGENT __ATOMIC_RELAXED, __HIP_MEMORY_SCOPE_AGENT
#define LDS_WAIT() asm volatile("s_waitcnt lgkmcnt(0)" ::: "memory")
#define VM_WAIT() asm volatile("s_waitcnt vmcnt(0)" ::: "memory")
__device__ __forceinline__ unsigned long long rt() { return __builtin_amdgcn_s_memrealtime(); }

#define XB_TMO      128
#define XB_XCNT(j)  (256  + 64 * (j))
#define XB_XSUB(j)  (1280 + 64 * (j))
#define XB_XGEN(j)  (2304 + 64 * (j))
#define XB_TOP      3328
#define XB_TOPGEN   3392
#define XCD_BAR_WORDS 3456
#define XB_SPIN_CAP (1u << 18)

__device__ __forceinline__ unsigned xb_ld(unsigned* p)              { return __hip_atomic_load(p, __ATOMIC_RELAXED, __HIP_MEMORY_SCOPE_AGENT); }
__device__ __forceinline__ unsigned xb_add(unsigned* p, unsigned v) { return __hip_atomic_fetch_add(p, v, __ATOMIC_RELAXED, __HIP_MEMORY_SCOPE_AGENT); }
__device__ __forceinline__ unsigned xb_xcc_id() { return (unsigned)__builtin_amdgcn_s_getreg((3 << 11) | 20) & 0xFu; }
#define XB_SPIN(cond, bar) do { unsigned _sp = 0; while (cond) { __builtin_amdgcn_s_sleep(1); \
    if ((++_sp & 255u) == 0u) { if (xb_ld(&(bar)[XB_TMO])) break; if (_sp > XB_SPIN_CAP) { atomicAdd(&(bar)[XB_TMO], 1u); break; } } } } while (0)

struct XcdBarrier {
    unsigned* bar; unsigned x; unsigned total;
    volatile LAS unsigned* st;
};

__device__ __forceinline__ XcdBarrier xcd_barrier_post(unsigned* bar, volatile LAS unsigned* st, unsigned total, bool member) {
    XcdBarrier b; b.bar = bar; b.x = xb_xcc_id(); b.st = st; b.total = total;
    if (member && threadIdx.x == 0) (void)xb_add(&bar[XB_XCNT(b.x)], 1u);
    return b;
}
__device__ __forceinline__ void xcd_barrier_complete(unsigned* bar, unsigned x, unsigned G, unsigned& nloc, unsigned& nx) {
    unsigned sum, cnt, mine, sp = 0u;
    for (;;) {
        sum = 0u; cnt = 0u; mine = 0u;
#pragma unroll
        for (unsigned j = 0; j < 16; ++j) { const unsigned c = xb_ld(&bar[XB_XCNT(j)]); sum += c; cnt += (c > 0u) ? 1u : 0u; mine = (j == x) ? c : mine; }
        if (sum == G) break;
        __builtin_amdgcn_s_sleep(1);
        if ((++sp & 255u) == 0u) { if (xb_ld(&bar[XB_TMO])) break; if (sp > XB_SPIN_CAP) { atomicAdd(&bar[XB_TMO], 1u); break; } }
    }
    nloc = mine > 0u ? mine : 1u; nx = cnt > 0u ? cnt : 1u;
}

__device__ __forceinline__ void xcd_barrier(const XcdBarrier& b) {
    asm volatile("s_waitcnt vmcnt(0)" ::: "memory");
    __syncthreads();
    if (threadIdx.x == 0) {
        unsigned* bar = b.bar;
        __builtin_amdgcn_s_waitcnt(0);
        unsigned nloc = b.st[0], nx = b.st[1];
        if (nloc == 0u) { xcd_barrier_complete(bar, b.x, b.total, nloc, nx); b.st[0] = nloc; b.st[1] = nx; }
        const unsigned old = xb_add(&bar[XB_XSUB(b.x)], 1u);
        const unsigned gen = old / nloc;
        if (old + 1u == (gen + 1u) * nloc) {
            __builtin_amdgcn_fence(__ATOMIC_RELEASE, "agent");
            asm volatile("s_waitcnt vmcnt(0)" ::: "memory");
            const unsigned og = xb_add(&bar[XB_TOP], 1u);
            const unsigned tg = og / nx;
            if (og + 1u == (tg + 1u) * nx) xb_add(&bar[XB_TOPGEN], 1u);
            else XB_SPIN(xb_ld(&bar[XB_TOPGEN]) == tg, bar);
            __builtin_amdgcn_fence(__ATOMIC_ACQUIRE, "agent");
            xb_add(&bar[XB_XGEN(b.x)], 1u);
            asm volatile("s_waitcnt vmcnt(0)" ::: "memory");
        } else {
            XB_SPIN(xb_ld(&bar[XB_XGEN(b.x)]) == gen, bar);
            __builtin_amdgcn_fence(__ATOMIC_ACQUIRE, "agent");
            asm volatile("s_waitcnt vmcnt(0)" ::: "memory");
        }
    }
    __syncthreads();
}
__device__ __forceinline__ int lane_tstart(const int* cnt, int lane, int& mycnt) {
    mycnt = (lane < NE) ? cnt[lane * CNT_STRIDE] : 0;
    const int tiles = (mycnt + 255) >> 8;
    int incl = tiles;
#pragma unroll
    for (int o = 1; o < 64; o <<= 1) { const int v = __shfl_up(incl, o); if (lane >= o) incl += v; }
    return incl - tiles;
}

__device__ __forceinline__ void xn_row(const float* __restrict__ x, const float* __restrict__ g, bf16* xn, int row, int lane) {
    const float4* xr = (const float4*)(x + (size_t)row * D) + lane;
    float4 v[4]; float s = 0.f;
#pragma unroll
    for (int j = 0; j < 4; ++j) { v[j] = xr[64 * j]; s += v[j].x * v[j].x + v[j].y * v[j].y + v[j].z * v[j].z + v[j].w * v[j].w; }
    s = wave_sum(s);
    const float r = rsqrtf(s * (1.f / D) + EPS);
    uint2* o = (uint2*)(xn + (size_t)row * D) + lane;
#pragma unroll
    for (int j = 0; j < 4; ++j) { const float4 gg = ((const float4*)g)[lane + 64 * j];
        uint2 w; w.x = pk2(v[j].x * r * gg.x, v[j].y * r * gg.y); w.y = pk2(v[j].z * r * gg.z, v[j].w * r * gg.w); o[64 * j] = w; }
}

__device__ __forceinline__ void combine_rows(const bf16* h16, float* out, const unsigned char* Y8, const int* cnt, const int* sel_e, const float* sel_gate,
                                             const int* sel_pos, const float* __restrict__ g, int m0, int stride, int lane) {
    int mycnt; const int ts = lane_tstart(cnt, lane, mycnt);
    for (int m = m0; m < T; m += 2 * stride) {
        const int rowv[2] = {m, (m + stride < T) ? m + stride : m};
        uint2 aw[2][4]; unsigned yw[2][4][4]; float gs[2][4]; float4 v[2][4];
#pragma unroll
        for (int p = 0; p < 2; ++p) { const int row = rowv[p];
            const uint2* ar = (const uint2*)(h16 + (size_t)row * D) + lane;
#pragma unroll
            for (int j = 0; j < 4; ++j) aw[p][j] = ar[64 * j];
#pragma unroll
            for (int k = 0; k < 4; ++k) { const int e = sel_e[row * 4 + k]; const int pos = sel_pos[row * 4 + k]; gs[p][k] = sel_gate[row * 4 + k] * (1.f / FP8_SY);
                const unsigned* yr = (const unsigned*)(Y8 + (size_t)(256 * __shfl(ts, e) + pos) * D) + lane;
#pragma unroll
                for (int j = 0; j < 4; ++j) yw[p][k][j] = yr[64 * j]; } }
#pragma unroll
        for (int p = 0; p < 2; ++p) { const int row = rowv[p];
            float s = 0.f;
#pragma unroll
            for (int j = 0; j < 4; ++j) { float4 a;
                a.x = __builtin_bit_cast(float, aw[p][j].x << 16); a.y = __builtin_bit_cast(float, aw[p][j].x & 0xffff0000u); a.z = __builtin_bit_cast(float, aw[p][j].y << 16); a.w = __builtin_bit_cast(float, aw[p][j].y & 0xffff0000u);
#pragma unroll
                for (int k = 0; k < 4; ++k) { const f32x2_t lo2 = __builtin_amdgcn_cvt_pk_f32_fp8((int)yw[p][k][j], false), hi2 = __builtin_amdgcn_cvt_pk_f32_fp8((int)yw[p][k][j], true);
                    a.x += gs[p][k] * lo2[0]; a.y += gs[p][k] * lo2[1]; a.z += gs[p][k] * hi2[0]; a.w += gs[p][k] * hi2[1]; }
                s += a.x * a.x + a.y * a.y + a.z * a.z + a.w * a.w; v[p][j] = a; }
            s = wave_sum(s);
            const float r = rsqrtf(s * (1.f / D) + EPS);
            float4* orow = (float4*)(out + (size_t)row * D) + lane;
#pragma unroll
            for (int j = 0; j < 4; ++j) { const float4 gg = ((const float4*)g)[lane + 64 * j];
                float4 w; w.x = v[p][j].x * r * gg.x; w.y = v[p][j].y * r * gg.y; w.z = v[p][j].z * r * gg.z; w.w = v[p][j].w * r * gg.w; orow[64 * j] = w; } }
    }
}

typedef float f32x16 __attribute__((ext_vector_type(16)));
typedef short s16x8 __attribute__((ext_vector_type(8)));
typedef unsigned v2u __attribute__((ext_vector_type(2)));
#define MFMA32(a, b, c) __builtin_amdgcn_mfma_f32_32x32x16_bf16((a), (b), (c), 0, 0, 0)
__device__ __forceinline__ int mrow(int reg, int hh) { return (reg & 3) + 8 * (reg >> 2) + 4 * hh; }
__device__ __forceinline__ v4u pack8(const float (&f)[8]) { v4u w; w.x = pk2(f[0], f[1]); w.y = pk2(f[2], f[3]); w.z = pk2(f[4], f[5]); w.w = pk2(f[6], f[7]); return w; }
__device__ __forceinline__ float bflo(unsigned w) { return __builtin_bit_cast(float, w << 16); }
__device__ __forceinline__ float bfhi(unsigned w) { return __builtin_bit_cast(float, w & 0xffff0000u); }

__device__ __forceinline__ void gla_decay(unsigned zc, const float (&w)[16], float ba, int lane, int wave, LAS unsigned* zl, LAS float* seg, float (&bcs)[8], float& blast) {
    zl[lane] = zc;
    float run = 0.f;
#pragma unroll
    for (int jj = 0; jj < 8; ++jj) {
        const v4u z0 = *(const LAS v4u*)(zl + jj * 8), z1 = *(const LAS v4u*)(zl + jj * 8 + 4);
        float a = ba;
        a += w[0] * bflo(z0.x) + w[1] * bfhi(z0.x) + w[2] * bflo(z0.y) + w[3] * bfhi(z0.y) + w[4] * bflo(z0.z) + w[5] * bfhi(z0.z) + w[6] * bflo(z0.w) + w[7] * bfhi(z0.w);
        a += w[8] * bflo(z1.x) + w[9] * bfhi(z1.x) + w[10] * bflo(z1.y) + w[11] * bfhi(z1.y) + w[12] * bflo(z1.z) + w[13] * bfhi(z1.z) + w[14] * bflo(z1.w) + w[15] * bfhi(z1.w);
        run += logsigmoid_fast(a) * (1.f / 16.f);
        bcs[jj] = run;
    }
    seg[wave * 64 + lane] = run;
    __syncthreads();
    float off = 0.f, tot = 0.f;
#pragma unroll
    for (int w8 = 0; w8 < 8; ++w8) { const float s = seg[w8 * 64 + lane]; tot += s; off += (w8 < wave) ? s : 0.f; }
#pragma unroll
    for (int jj = 0; jj < 8; ++jj) bcs[jj] += off;
    blast = tot;
}
struct T16 { v4u x0, x1; };
__device__ __forceinline__ T16 load_T16(const bf16* src, size_t ld, int lane, int wave) { const v4u* sp = (const v4u*)(src + (size_t)lane * ld + wave * 16); T16 t; t.x0 = sp[0]; t.x1 = sp[1]; return t; }
__device__ __forceinline__ void store_T16(const T16& t, LAS bf16* dst, int lane, int wave) {
    const unsigned w[8] = {t.x0.x, t.x0.y, t.x0.z, t.x0.w, t.x1.x, t.x1.y, t.x1.z, t.x1.w};
    LAS bf16* d = dst + (wave * 16) * 72 + lane;
#pragma unroll
    for (int i = 0; i < 8; ++i) { d[(2 * i) * 72] = (bf16)(w[i] & 0xffffu); d[(2 * i + 1) * 72] = (bf16)(w[i] >> 16); }
}
__device__ __forceinline__ void gla_publish(LAS float* BL, LAS float* BLAST, const float (&bcs)[8], float blast, int lane, int wave) {
#pragma unroll
    for (int jj = 0; jj < 8; ++jj) BL[(wave * 8 + jj) * 68 + lane] = bcs[jj];
    if (wave == 0) BLAST[lane] = blast;
}

struct GlaARaw { v4u kr; T16 vraw; unsigned zc; float wup[16]; float ba; };
__device__ __forceinline__ GlaARaw gla_a_load(int u, const bf16* PROJ, const float* __restrict__ wup, const float* __restrict__ balpha, int lane, int wave) {
    const int bh = u >> 7, c = u & 127, b = bh >> 2, h = bh & 3;
    const bf16* prow0 = PROJ + (size_t)(b * SEQ + c * 64) * DINP;
    GlaARaw w; w.kr = *(const v4u*)(prow0 + (size_t)lane * DINP + C_KA + h * 64 + wave * 8); w.vraw = load_T16(prow0 + C_VA + h * 128, DINP, lane, wave);
    w.zc = *(const unsigned*)(prow0 + (size_t)(wave * 8 + (lane >> 3)) * DINP + C_ZA + 2 * (lane & 7));
#pragma unroll
    for (int r = 0; r < 16; ++r) w.wup[r] = wup[r * 256 + h * 64 + lane];
    w.ba = balpha[h * 64 + lane];
    return w;
}
__device__ __forceinline__ void gla_a_unit(int u, const GlaARaw& w, const bf16* PROJ, const float* __restrict__ wup, const float* __restrict__ balpha, float* KV, float* DECAY, float* BLG,
                                           LAS unsigned char* lds, int tid, int lane, int wave) {
    const int bh = u >> 7, c = u & 127, b = bh >> 2, h = bh & 3;
    const bf16* prow0 = PROJ + (size_t)(b * SEQ + c * 64) * DINP;
    LAS bf16* KT = (LAS bf16*)lds; LAS bf16* VT = (LAS bf16*)(lds + 9216); LAS float* seg = (LAS float*)(lds + 27648);
    LAS float* BL = (LAS float*)(lds + 29696); LAS float* BLAST = (LAS float*)(lds + 47104);
    const v4u kr = w.kr; const T16 vraw = w.vraw;
    float bcs[8], blast;
    gla_decay(w.zc, w.wup, w.ba, lane, wave, (LAS unsigned*)(lds + 47360 + wave * 256), seg, bcs, blast);
    gla_publish(BL, BLAST, bcs, blast, lane, wave);
    if (wave == 0) DECAY[u * 64 + lane] = __expf(blast);
    { float* bg = BLG + (size_t)u * 4096 + (wave * 8) * 64 + lane;
#pragma unroll
      for (int jj = 0; jj < 8; ++jj) bg[jj * 64] = bcs[jj]; }
    __syncthreads();
    {
      const f32x4 b0 = *(const LAS f32x4*)(BL + lane * 68 + wave * 8), b1 = *(const LAS f32x4*)(BL + lane * 68 + wave * 8 + 4);
      const f32x4 l0 = *(const LAS f32x4*)(BLAST + wave * 8), l1 = *(const LAS f32x4*)(BLAST + wave * 8 + 4);
      const unsigned kw[4] = {kr.x, kr.y, kr.z, kr.w};
      LAS bf16* d = KT + (wave * 8) * 72 + lane;
#pragma unroll
      for (int i = 0; i < 4; ++i) { const float e0 = (i < 2 ? l0[2 * i] - b0[2 * i] : l1[2 * i - 4] - b1[2 * i - 4]), e1 = (i < 2 ? l0[2 * i + 1] - b0[2 * i + 1] : l1[2 * i - 3] - b1[2 * i - 3]);
          d[(2 * i) * 72] = (bf16)f2bf(bflo(kw[i]) * __expf(e0)); d[(2 * i + 1) * 72] = (bf16)f2bf(bfhi(kw[i]) * __expf(e1)); } }
    store_T16(vraw, VT, lane, wave);
    __syncthreads();
    const int r = lane & 31, hh = lane >> 5, dt = wave & 1, vt = wave >> 1;
    f32x16 acc = {};
#pragma unroll
    for (int ks = 0; ks < 4; ++ks) {
        const s16x8 a = *(const LAS s16x8*)(KT + (dt * 32 + r) * 72 + ks * 16 + 8 * hh);
        const s16x8 bb = *(const LAS s16x8*)(VT + (vt * 32 + r) * 72 + ks * 16 + 8 * hh);
        acc = MFMA32(a, bb, acc);
    }
    float* kvp = KV + (size_t)u * 8192 + vt * 32 + r;
#pragma unroll
    for (int reg = 0; reg < 16; ++reg) kvp[(dt * 32 + mrow(reg, hh)) * 128] = acc[reg];
    __syncthreads();
}
__device__ __forceinline__ void gla_scan(int id, const float* KV, const float* DECAY, bf16* SPREV) {
    const int bh = id >> 13, dv = id & 8191, d = dv >> 7;
    float S = 0.f;
    const size_t base = (size_t)bh * 128 * 8192 + dv;
#pragma unroll 32
    for (int c = 0; c < 128; ++c) {
        const float kv = KV[base + (size_t)c * 8192];
        const float dec = DECAY[(bh * 128 + c) * 64 + d];
        SPREV[base + (size_t)c * 8192] = (bf16)f2bf(S);
        S = dec * S + kv;
    }
}
struct GlaCRaw { v4u qr, kr; T16 vraw, sraw; v4u rg0, rg1; f32x4 b0, b1; };
__device__ __forceinline__ GlaCRaw gla_c_load(int u, const bf16* PROJ, const float* BLG, const bf16* SPREV, int tid, int lane, int wave) {
    const int bh = u >> 7, c = u & 127, b = bh >> 2, h = bh & 3;
    const size_t row0 = (size_t)b * SEQ + c * 64;
    const bf16* prow0 = PROJ + row0 * DINP;
    GlaCRaw w;
    w.qr = *(const v4u*)(prow0 + (size_t)lane * DINP + C_QA + h * 64 + wave * 8); w.kr = *(const v4u*)(prow0 + (size_t)lane * DINP + C_KA + h * 64 + wave * 8);
    w.vraw = load_T16(prow0 + C_VA + h * 128, DINP, lane, wave); w.sraw = load_T16(SPREV + (size_t)u * 8192, 128, lane, wave);
    const v4u* rp_ = (const v4u*)(PROJ + (row0 + (tid >> 3)) * DINP + C_RA + h * 128 + (tid & 7) * 16);
    w.rg0 = rp_[0]; w.rg1 = rp_[1];
    w.b0 = *(const f32x4*)(BLG + (size_t)u * 4096 + lane * 64 + wave * 8); w.b1 = *(const f32x4*)(BLG + (size_t)u * 4096 + lane * 64 + wave * 8 + 4);
    return w;
}
__device__ __forceinline__ void gla_c_unit(int u, const GlaCRaw& w, const float* __restrict__ gnorm, bf16* CAT, LAS unsigned char* lds, int tid, int lane, int wave) {
    const int bh = u >> 7, c = u & 127, b = bh >> 2, h = bh & 3;
    const size_t row0 = (size_t)b * SEQ + c * 64;
    LAS bf16* QE = (LAS bf16*)lds; LAS bf16* KE = (LAS bf16*)(lds + 9216); LAS bf16* AM = (LAS bf16*)(lds + 18432);
    LAS bf16* VT = (LAS bf16*)(lds + 27648); LAS bf16* ST = (LAS bf16*)(lds + 46080); LAS float* OB = (LAS float*)(lds + 64512);
    const v4u qr = w.qr, kr = w.kr, rg0 = w.rg0, rg1 = w.rg1; const f32x4 b0 = w.b0, b1 = w.b1; const T16 vraw = w.vraw, sraw = w.sraw;
    {
      const unsigned qw[4] = {qr.x, qr.y, qr.z, qr.w}, kw[4] = {kr.x, kr.y, kr.z, kr.w};
      float qe[8], ke[8];
#pragma unroll
      for (int i = 0; i < 4; ++i) { const float ba = (i < 2 ? b0[2 * i] : b1[2 * i - 4]), bb = (i < 2 ? b0[2 * i + 1] : b1[2 * i - 3]);
          const float ea = __expf(ba), eb = __expf(bb);
          qe[2 * i] = bflo(qw[i]) * 0.125f * ea; qe[2 * i + 1] = bfhi(qw[i]) * 0.125f * eb;
          ke[2 * i] = bflo(kw[i]) * __builtin_amdgcn_rcpf(ea); ke[2 * i + 1] = bfhi(kw[i]) * __builtin_amdgcn_rcpf(eb); }
      *(LAS v4u*)(QE + lane * 72 + wave * 8) = pack8(qe); *(LAS v4u*)(KE + lane * 72 + wave * 8) = pack8(ke); }
    store_T16(vraw, VT, lane, wave);
    store_T16(sraw, ST, lane, wave);
    __syncthreads();
    const int r = lane & 31, hh = lane >> 5;
    if (wave < 3) {
        const int it = wave ? 1 : 0, jt = wave == 2 ? 1 : 0;
        f32x16 acc = {};
#pragma unroll
        for (int ks = 0; ks < 4; ++ks) {
            const s16x8 a = *(const LAS s16x8*)(QE + (it * 32 + r) * 72 + ks * 16 + 8 * hh);
            const s16x8 bb = *(const LAS s16x8*)(KE + (jt * 32 + r) * 72 + ks * 16 + 8 * hh);
            acc = MFMA32(a, bb, acc);
        }
        const int j = jt * 32 + r;
#pragma unroll
        for (int reg = 0; reg < 16; ++reg) { const int i = it * 32 + mrow(reg, hh); AM[i * 72 + j] = (bf16)f2bf(j <= i ? acc[reg] : 0.f); }
    } else if (wave == 3) {
#pragma unroll
        for (int reg = 0; reg < 16; ++reg) AM[mrow(reg, hh) * 72 + 32 + r] = 0;
    }
    __syncthreads();
    { const int it = wave & 1, vt = wave >> 1;
      f32x16 acc = {};
#pragma unroll
      for (int ks = 0; ks < 4; ++ks) {
          const s16x8 a = *(const LAS s16x8*)(AM + (it * 32 + r) * 72 + ks * 16 + 8 * hh);
          const s16x8 bb = *(const LAS s16x8*)(VT + (vt * 32 + r) * 72 + ks * 16 + 8 * hh);
          acc = MFMA32(a, bb, acc);
      }
#pragma unroll
      for (int ks = 0; ks < 4; ++ks) {
          const s16x8 a = *(const LAS s16x8*)(QE + (it * 32 + r) * 72 + ks * 16 + 8 * hh);
          const s16x8 bb = *(const LAS s16x8*)(ST + (vt * 32 + r) * 72 + ks * 16 + 8 * hh);
          acc = MFMA32(a, bb, acc);
      }
#pragma unroll
      for (int reg = 0; reg < 16; ++reg) OB[(it * 32 + mrow(reg, hh)) * 132 + vt * 32 + r] = acc[reg]; }
    __syncthreads();
    { const int i = tid >> 3, s8 = tid & 7;
      float o[16]; float ss = 0.f;
#pragma unroll
      for (int q4 = 0; q4 < 4; ++q4) { const f32x4 t4 = *(const LAS f32x4*)(OB + i * 132 + s8 * 16 + q4 * 4); o[4 * q4] = t4[0]; o[4 * q4 + 1] = t4[1]; o[4 * q4 + 2] = t4[2]; o[4 * q4 + 3] = t4[3]; }
#pragma unroll
      for (int q = 0; q < 16; ++q) ss += o[q] * o[q];
      ss += __shfl_xor(ss, 1); ss += __shfl_xor(ss, 2); ss += __shfl_xor(ss, 4);
      const float rstd = rsqrtf(ss * (1.f / 128.f) + EPS);
      const unsigned rw[8] = {rg0.x, rg0.y, rg0.z, rg0.w, rg1.x, rg1.y, rg1.z, rg1.w};
      float res[16];
#pragma unroll
      for (int q = 0; q < 8; ++q) { const float ra = bflo(rw[q]), rb = bfhi(rw[q]);
          res[2 * q] = o[2 * q] * rstd * gnorm[s8 * 16 + 2 * q] * (ra * __builtin_amdgcn_rcpf(1.f + __builtin_amdgcn_exp2f(-1.4426950408889634f * ra)));
          res[2 * q + 1] = o[2 * q + 1] * rstd * gnorm[s8 * 16 + 2 * q + 1] * (rb * __builtin_amdgcn_rcpf(1.f + __builtin_amdgcn_exp2f(-1.4426950408889634f * rb))); }
      uint4 w0, w1;
      w0.x = pk2(res[0], res[1]); w0.y = pk2(res[2], res[3]); w0.z = pk2(res[4], res[5]); w0.w = pk2(res[6], res[7]);
      w1.x = pk2(res[8], res[9]); w1.y = pk2(res[10], res[11]); w1.z = pk2(res[12], res[13]); w1.w = pk2(res[14], res[15]);
      uint4* op = (uint4*)(CAT + (row0 + i) * D + h * 128 + s8 * 16);
      op[0] = w0; op[1] = w1; }
    __syncthreads();
}

struct SwaRaw { v4u k[3], v[3]; s16x8 qf[4]; };
__device__ __forceinline__ SwaRaw swa_load(int s, const bf16* PROJ, int tid, int lane, int wave) {
    const int b = s >> 8, kvh = (s >> 7) & 1, qt = s & 127, q0 = qt * 64;
    const size_t rowb = (size_t)b * SEQ;
    SwaRaw w;
#pragma unroll
    for (int i = 0; i < 3; ++i) { const int id = tid + 512 * i, kk = id >> 3, ch = id & 7; int tok = q0 - 128 + kk; tok = tok < 0 ? 0 : tok;
        w.k[i] = *(const v4u*)(PROJ + (rowb + tok) * DINP + C_KB + kvh * 64 + ch * 8); }
#pragma unroll
    for (int g3 = 0; g3 < 3; ++g3) { int tok = q0 - 128 + 64 * g3 + lane; tok = tok < 0 ? 0 : tok;
        w.v[g3] = *(const v4u*)(PROJ + (rowb + tok) * DINP + C_VB + kvh * 64 + wave * 8); }
    const int r = lane & 31, hh = lane >> 5, g = wave >> 1, half = wave & 1, hq = kvh * 4 + g;
    const bf16* qp = PROJ + (rowb + q0 + half * 32 + r) * DINP + C_QB + hq * 64 + 8 * hh;
#pragma unroll
    for (int ks = 0; ks < 4; ++ks) w.qf[ks] = *(const s16x8*)(qp + ks * 16);
    return w;
}
__device__ __forceinline__ void swa_unit(int s, const SwaRaw& w, const float* __restrict__ sinks, const float* __restrict__ gnorm, bf16* CAT,
                                         LAS unsigned char* lds, int tid, int lane, int wave) {
    const int b = s >> 8, kvh = (s >> 7) & 1, qt = s & 127, q0 = qt * 64;
    const size_t rowb = (size_t)b * SEQ;
    LAS bf16* KS = (LAS bf16*)lds; LAS bf16* VT = (LAS bf16*)(lds + 27648); LAS bf16* STG = (LAS bf16*)(lds + 53248 + wave * 4608);
#pragma unroll
    for (int i = 0; i < 3; ++i) { const int id = tid + 512 * i, kk = id >> 3, ch = id & 7; *(LAS v4u*)(KS + kk * 72 + ch * 8) = w.k[i]; }
#pragma unroll
    for (int g3 = 0; g3 < 3; ++g3) { const int kk = 64 * g3 + lane; const unsigned wv[4] = {w.v[g3].x, w.v[g3].y, w.v[g3].z, w.v[g3].w};
        LAS bf16* d = VT + (wave * 8) * 200 + kk;
#pragma unroll
        for (int i = 0; i < 4; ++i) { d[(2 * i) * 200] = (bf16)(wv[i] & 0xffffu); d[(2 * i + 1) * 200] = (bf16)(wv[i] >> 16); } }
    const int r = lane & 31, hh = lane >> 5, g = wave >> 1, half = wave & 1, hq = kvh * 4 + g;
    s16x8 qf[4];
#pragma unroll
    for (int ks = 0; ks < 4; ++ks) qf[ks] = w.qf[ks];
    __syncthreads();
    const float L2E = 1.4426950408889634f;
    const float slope2 = exp2f(-(float)(hq + 1)) * L2E, sink2 = sinks[hq] * L2E;
    const int rl = r - 4 * hh, kmin = 128 - q0 - 32 * half - 4 * hh;
    const float fbl = slope2 * (float)rl;
    float m = sink2;
    f32x16 sc[5];
#pragma unroll
    for (int blk = 0; blk < 5; ++blk) { sc[blk] = (f32x16){};
#pragma unroll
        for (int ks = 0; ks < 4; ++ks) { const s16x8 a = *(const LAS s16x8*)(KS + (32 * (half + blk) + r) * 72 + ks * 16 + 8 * hh); sc[blk] = MFMA32(a, qf[ks], sc[blk]); }
        if (blk >= 1 && blk <= 3 && q0 >= 128) {
#pragma unroll
            for (int reg = 0; reg < 16; ++reg) { const int c1 = 128 - (32 * blk + (reg & 3) + 8 * (reg >> 2));
                const float v = fmaf(sc[blk][reg], 0.125f * L2E, -(fbl + slope2 * (float)c1));
                sc[blk][reg] = v; m = fmaxf(m, v); }
        } else {
#pragma unroll
            for (int reg = 0; reg < 16; ++reg) { const int c2 = 32 * blk + (reg & 3) + 8 * (reg >> 2), c1 = 128 - c2;
                const bool valid = ((unsigned)(rl + c1) < 128u) && (c2 >= kmin);
                const float v = valid ? fmaf(sc[blk][reg], 0.125f * L2E, -(fbl + slope2 * (float)c1)) : -INFINITY;
                sc[blk][reg] = v; m = fmaxf(m, v); }
        }
        __builtin_amdgcn_sched_barrier(0);
    }
    m = fmaxf(m, __shfl_xor(m, 32));
    float l = 0.f;
    f32x16 o[2]; o[0] = (f32x16){}; o[1] = (f32x16){};
#pragma unroll
    for (int blk = 0; blk < 5; ++blk) {
        float p[16];
#pragma unroll
        for (int reg = 0; reg < 16; ++reg) { p[reg] = __builtin_amdgcn_exp2f(sc[blk][reg] - m); l += p[reg]; }
#pragma unroll
        for (int s2 = 0; s2 < 2; ++s2) {
            v4u pw; pw.x = pk2(p[8 * s2], p[8 * s2 + 1]); pw.y = pk2(p[8 * s2 + 2], p[8 * s2 + 3]); pw.z = pk2(p[8 * s2 + 4], p[8 * s2 + 5]); pw.w = pk2(p[8 * s2 + 6], p[8 * s2 + 7]);
            const s16x8 pf = __builtin_bit_cast(s16x8, pw);
            const int base = 32 * (half + blk) + 16 * s2 + 4 * hh;
#pragma unroll
            for (int db = 0; db < 2; ++db) {
                const v2u lo = *(const LAS v2u*)(VT + (db * 32 + r) * 200 + base), hi = *(const LAS v2u*)(VT + (db * 32 + r) * 200 + base + 8);
                v4u aw; aw.x = lo.x; aw.y = lo.y; aw.z = hi.x; aw.w = hi.y;
                o[db] = MFMA32(__builtin_bit_cast(s16x8, aw), pf, o[db]);
            }
        }
        __builtin_amdgcn_sched_barrier(0);
    }
    l += __shfl_xor(l, 32);
    l += __builtin_amdgcn_exp2f(sink2 - m);
    const float inv_l = 1.f / l;
    float ss = 0.f;
#pragma unroll
    for (int db = 0; db < 2; ++db)
#pragma unroll
        for (int reg = 0; reg < 16; ++reg) { o[db][reg] *= inv_l; ss += o[db][reg] * o[db][reg]; }
    ss += __shfl_xor(ss, 32);
    const float rstd = rsqrtf(ss * (1.f / 64.f) + EPS);
#pragma unroll
    for (int db = 0; db < 2; ++db)
#pragma unroll
        for (int rq = 0; rq < 4; ++rq) { const float4 gg = *(const float4*)(gnorm + db * 32 + 8 * rq + 4 * hh);
            const int dv = db * 32 + 8 * rq + 4 * hh;
            STG[r * 72 + dv + 0] = (bf16)f2bf(o[db][4 * rq + 0] * rstd * gg.x); STG[r * 72 + dv + 1] = (bf16)f2bf(o[db][4 * rq + 1] * rstd * gg.y);
            STG[r * 72 + dv + 2] = (bf16)f2bf(o[db][4 * rq + 2] * rstd * gg.z); STG[r * 72 + dv + 3] = (bf16)f2bf(o[db][4 * rq + 3] * rstd * gg.w); }
    asm volatile("s_waitcnt lgkmcnt(0)" ::: "memory");
#pragma unroll
    for (int it = 0; it < 4; ++it) { const int q = (lane >> 3) + 8 * it, ch = lane & 7;
        const v4u v = *(const LAS v4u*)(STG + q * 72 + ch * 8);
        *(v4u*)(CAT + (rowb + q0 + half * 32 + q) * D + 512 + hq * 64 + ch * 8) = v; }
    __syncthreads();
}

__device__ __forceinline__ void router_block(int blk, const float* __restrict__ X, bf16* ATT  , const float* __restrict__ g2, const bf16* WRH, const bf16* WRL, const float* __restrict__ br,
                                             bf16* HN, float* RSTD, int* cnt, int* tok_list, int* sel_e, float* sel_gate, int* sel_pos,
                                             LAS unsigned char* lds, int tid, int lane, int wave) {
    LAS unsigned char* reg_w = lds + wave * 16384;
    const int r = lane & 31, hh = lane >> 5, t = wave >> 2, q = wave & 3;
    const size_t row0 = (size_t)blk * 64 + t * 32;
    const int c4 = 4 * r;
    f32x16 acc = {};
    float sq[16];
#pragma unroll
    for (int i = 0; i < 16; ++i) sq[i] = 0.f;
#pragma unroll 1
    for (int sc = 0; sc < 2; ++sc) {
        const int kb = q * 256 + sc * 128;
        const float4 gg = *(const float4*)(g2 + kb + c4);
#pragma unroll
        for (int i = 0; i < 16; ++i) {
            const int rw = 2 * i + hh; const size_t grow = row0 + rw;
            float4 h = *(const float4*)(X + grow * D + kb + c4);
            const uint2 aw = *(const uint2*)(ATT + grow * D + kb + c4);
            h.x += bflo(aw.x); h.y += bfhi(aw.x); h.z += bflo(aw.y); h.w += bfhi(aw.y);
            sq[i] += h.x * h.x + h.y * h.y + h.z * h.z + h.w * h.w;
            { uint2 hw; hw.x = pk2(h.x, h.y); hw.y = pk2(h.z, h.w); *(uint2*)(ATT + grow * D + kb + c4) = hw; }
            const float x0 = h.x * gg.x, x1 = h.y * gg.y, x2 = h.z * gg.z, x3 = h.w * gg.w;
            v2u vh, vl; vh.x = pk2(x0, x1); vh.y = pk2(x2, x3);
            vl.x = pk2(x0 - bflo(vh.x), x1 - bfhi(vh.x)); vl.y = pk2(x2 - bflo(vh.y), x3 - bfhi(vh.y));
            const int off = rw * 256 + (((r >> 1) ^ (rw & 15)) << 4) + ((r & 1) << 3);
            *(LAS v2u*)(reg_w + off) = vh; *(LAS v2u*)(reg_w + 8192 + off) = vl;
#if MOE_FP8
            *(unsigned*)((unsigned char*)HN + grow * D + kb + c4) = pg8::pack4_fp8(x0 * FP8_SA, x1 * FP8_SA, x2 * FP8_SA, x3 * FP8_SA);
#else
            *(v2u*)(HN + grow * D + kb + c4) = vh;
#endif
        }
#pragma unroll
        for (int ks = 0; ks < 8; ++ks) {
            const int off = r * 256 + (((2 * ks + hh) ^ (r & 15)) << 4);
            const s16x8 fh = *(const LAS s16x8*)(reg_w + off), fl = *(const LAS s16x8*)(reg_w + 8192 + off);
            const s16x8 wh = *(const s16x8*)(WRH + (size_t)r * D + kb + ks * 16 + 8 * hh), wl = *(const s16x8*)(WRL + (size_t)r * D + kb + ks * 16 + 8 * hh);
            acc = MFMA32(fh, wh, acc); acc = MFMA32(fh, wl, acc); acc = MFMA32(fl, wh, acc);
        }
    }
    { const bool b4 = r & 16, b3 = r & 8, b2 = r & 4, b1 = r & 2;
      float s8[8], s4[4], s2[2], s1;
#pragma unroll
      for (int j = 0; j < 8; ++j) s8[j] = (b4 ? sq[j + 8] : sq[j]) + __shfl_xor(b4 ? sq[j] : sq[j + 8], 16);
#pragma unroll
      for (int j = 0; j < 4; ++j) s4[j] = (b3 ? s8[j + 4] : s8[j]) + __shfl_xor(b3 ? s8[j] : s8[j + 4], 8);
#pragma unroll
      for (int j = 0; j < 2; ++j) s2[j] = (b2 ? s4[j + 2] : s4[j]) + __shfl_xor(b2 ? s4[j] : s4[j + 2], 4);
      s1 = (b1 ? s2[1] : s2[0]) + __shfl_xor(b1 ? s2[0] : s2[1], 2);
      s1 += __shfl_xor(s1, 1);
      const int i = (b4 ? 8 : 0) + (b3 ? 4 : 0) + (b2 ? 2 : 0) + (b1 ? 1 : 0);
      LAS float* SQw = (LAS float*)(reg_w + 4096);
      if (!(r & 1)) SQw[2 * i + hh] = s1; }
    { LAS float* PARTw = (LAS float*)reg_w;
#pragma unroll
      for (int reg = 0; reg < 16; ++reg) PARTw[mrow(reg, hh) * 32 + r] = acc[reg]; }
    __syncthreads();
#define PART_AT(w_, m_, e_) (*(const LAS float*)(lds + (w_) * 16384 + ((m_) * 32 + (e_)) * 4))
#define SQ_AT(w_, m_) (*(const LAS float*)(lds + (w_) * 16384 + 4096 + (m_) * 4))
    LAS int* lcnt = (LAS int*)(lds + 8192); LAS int* lbase = lcnt + 32;
    if (tid < 32) lcnt[tid] = 0;
    __syncthreads();
    int s_ex[4], s_lp[4]; float s_gt[4];
#pragma unroll
    for (int it = 0; it < 4; ++it) {
        const int rl = wave * 8 + it * 2 + hh, tt = rl >> 5, m = rl & 31, e = r;
        float lg = 0.f, ss = 0.f;
#pragma unroll
        for (int qq = 0; qq < 4; ++qq) { lg += PART_AT(tt * 4 + qq, m, e); ss += SQ_AT(tt * 4 + qq, m); }
        const float rstd = rsqrtf(ss * (1.f / D) + EPS);
        float cur = lg * rstd + br[e];
        float tv[4]; int ti[4];
#pragma unroll
        for (int k = 0; k < 4; ++k) {
            float mx = cur;
#pragma unroll
            for (int o = 1; o < 32; o <<= 1) mx = fmaxf(mx, __shfl_xor(mx, o));
            int idx = (cur == mx) ? e : 99;
#pragma unroll
            for (int o = 1; o < 32; o <<= 1) idx = min(idx, __shfl_xor(idx, o));
            tv[k] = mx; ti[k] = idx;
            if (e == idx) cur = -INFINITY;
        }
        const float e1 = __expf(tv[1] - tv[0]), e2 = __expf(tv[2] - tv[0]), e3 = __expf(tv[3] - tv[0]);
        const float inv = 1.f / (1.f + e1 + e2 + e3);
        s_ex[it] = e == 0 ? ti[0] : e == 1 ? ti[1] : e == 2 ? ti[2] : ti[3];
        s_gt[it] = (e == 0 ? 1.f : e == 1 ? e1 : e == 2 ? e2 : e3) * inv;
        s_lp[it] = 0;
        if (e < 4) s_lp[it] = __hip_atomic_fetch_add(&lcnt[s_ex[it]], 1, __ATOMIC_RELAXED, __HIP_MEMORY_SCOPE_WORKGROUP);
        if (e == 4) RSTD[blk * 64 + rl] = rstd;
    }
    __syncthreads();
    if (tid < 32) { const int n = lcnt[tid]; lbase[tid] = n ? atomicAdd(&cnt[tid * CNT_STRIDE], n) : 0; }
    __syncthreads();
    if (r < 4) {
#pragma unroll
        for (int it = 0; it < 4; ++it) { const int grow = blk * 64 + wave * 8 + it * 2 + hh, pos = lbase[s_ex[it]] + s_lp[it];
            tok_list[s_ex[it] * T + pos] = grow;
            sel_e[grow * 4 + r] = s_ex[it]; sel_gate[grow * 4 + r] = s_gt[it]; sel_pos[grow * 4 + r] = pos; }
    }
    __syncthreads();
}
constexpr int NWAVES = 8;
constexpr int RING_BYTES = 131072;
constexpr int LDSCTL_OFF = RING_BYTES, MISC_OFF = LDSCTL_OFF + 320;
constexpr int TAB_OFF = RING_BYTES + 1024;
constexpr int ROWS_OFF = TAB_OFF + 512;
constexpr int LDS_BYTES = 163840, ROWTABS = 14;
constexpr int RSTD_OFF = ROWS_OFF + ROWTABS * 1024;
static_assert(RSTD_OFF + ROWTABS * 1024 <= LDS_BYTES, "LDS map");

#ifndef MOE_W_ITEMS
#define MOE_W_ITEMS 20480
#endif
enum Phase { PH_PROLOGUE = 0, PH_INPROJ, PH_GLA_A, PH_SCAN, PH_GLA_C, PH_OUTPROJ, PH_ROUTER, PH_MOE1, PH_MOE2, PH_COMBINE, PH_N };

struct Args { const float* in[19]; float* out; unsigned char* ws; int ph_lo, ph_hi, li, pad; };

struct GridOrder {
    int nN, nunits, G, v;
    __device__ __forceinline__ bool next(int i, pg8::Unit& u) const {
        const int L = i * G + v; if (L >= nunits) return false;
        const int gs = 8 * nN, grp = L / gs, rem = L % gs;
        u.pm = grp * 8 + (rem & 7); u.pn = rem >> 3; u.am = u.pm; u.bn = u.pn; u.e = 0; u.ui = i; u.skip = 0; u.kind = 0; return true;
    }
    __device__ __forceinline__ const LAS int* rows(int) const { return nullptr; }
    __device__ __forceinline__ const char* abase(const pg8::Unit&) const { return nullptr; }
    __device__ __forceinline__ const char* bbase(const pg8::Unit&, size_t) const { return nullptr; }
    __device__ __forceinline__ void a_ready(const pg8::Unit&) const {}
    __device__ __forceinline__ void done(const pg8::Unit&) const {}
};
struct MoeOrder {
    const LAS int* tstart; const LAS int* rowtab; int ncol, ntile, G, v;
    __device__ __forceinline__ static int expert_of(const LAS int* ts, int R) { int e = 0;
#pragma unroll
        for (int j = 1; j < NE; ++j) e += (ts[j] <= R) ? 1 : 0;
        return e; }
    __device__ __forceinline__ bool map(int i, int& R, int& pn) const {
        const int li = i * G + v; if (li >= ntile * ncol) return false;
        R = li / ncol; pn = li % ncol; return true;
    }
    __device__ __forceinline__ bool next(int i, pg8::Unit& u) const {
        int R, pn; if (!map(i, R, pn)) return false;
        u.pm = R; u.pn = pn; u.am = R; u.e = expert_of(tstart, R); u.bn = u.e * ncol + pn; u.ui = i; u.skip = 0; u.kind = 0;
        return true;
    }
    __device__ __forceinline__ const LAS int* rows(int ui) const { return rowtab + ui * 256; }
    __device__ __forceinline__ const char* abase(const pg8::Unit&) const { return nullptr; }
    __device__ __forceinline__ const char* bbase(const pg8::Unit&, size_t) const { return nullptr; }
    __device__ __forceinline__ void a_ready(const pg8::Unit&) const {}
    __device__ __forceinline__ void done(const pg8::Unit&) const {}
};

struct P0Item { const float* W; unsigned char* WT; int ldw, ncols, k0, n0, dst_row0; };
__device__ __forceinline__ void p0_load(const P0Item& t, float4 (&v)[8], int lane) {
    const int c = t.n0 + 4 * (lane & 7);
#pragma unroll
    for (int i = 0; i < 8; ++i) { const int kk = (lane >> 3) + 8 * i; v[i] = (c < t.ncols) ? *(const float4*)(t.W + (size_t)(t.k0 + kk) * t.ldw + c) : make_float4(0.f, 0.f, 0.f, 0.f); }
}
template <bool F8> __device__ __forceinline__ void p0_finish(const P0Item& t, const float4 (&v)[8], LAS float* scr, int lane) {
#pragma unroll
    for (int i = 0; i < 8; ++i) { LAS float* d = scr + ((lane >> 3) + 8 * i) * 33 + 4 * (lane & 7); d[0] = v[i].x; d[1] = v[i].y; d[2] = v[i].z; d[3] = v[i].w; }
    LDS_WAIT(); asm volatile("" ::: "memory");
    const int c8 = lane & 7;
#pragma unroll
    for (int j = 0; j < 4; ++j) { const int n = (lane >> 3) + 8 * j; const LAS float* s = scr + (8 * c8) * 33 + n;
        if constexpr (F8) { typedef unsigned u32x2 __attribute__((ext_vector_type(2))); u32x2 o8;
            o8.x = pg8::pack4_fp8(s[0 * 33] * FP8_SW, s[1 * 33] * FP8_SW, s[2 * 33] * FP8_SW, s[3 * 33] * FP8_SW); o8.y = pg8::pack4_fp8(s[4 * 33] * FP8_SW, s[5 * 33] * FP8_SW, s[6 * 33] * FP8_SW, s[7 * 33] * FP8_SW);
            *(u32x2*)(t.WT + (size_t)(t.dst_row0 + n) * 1024 + t.k0 + 8 * c8) = o8; }
        else { v4u o; o.x = pk2(s[0 * 33], s[1 * 33]); o.y = pk2(s[2 * 33], s[3 * 33]); o.z = pk2(s[4 * 33], s[5 * 33]); o.w = pk2(s[6 * 33], s[7 * 33]);
            *(v4u*)((bf16*)t.WT + (size_t)(t.dst_row0 + n) * 1024 + t.k0 + 8 * c8) = o; } }
    LDS_WAIT(); asm volatile("" ::: "memory");
}
constexpr int P0_IN_ITEMS = 16 * 80, P0_OUT_ITEMS = 16 * 32, P0_SMALL_ITEMS = P0_IN_ITEMS + P0_OUT_ITEMS, P0_EXP_ITEMS = 3 * 512, P0_MOE_ITEMS = NE * P0_EXP_ITEMS;
__device__ __forceinline__ P0Item p0_small_item(const Args& a, int it) {
    if (it < P0_IN_ITEMS) { const int kb = it / 80, nb = it % 80; return P0Item{a.in[2], a.ws + WS_WIN, DIN, DIN, 64 * kb, 32 * nb, 32 * nb}; }
    it -= P0_IN_ITEMS; const int kb = it / 32, nb = it % 32; return P0Item{a.in[8], a.ws + WS_WOUT, D, D, 64 * kb, 32 * nb, 32 * nb};
}
__device__ __forceinline__ P0Item p0_moe_item(const Args& a, int it) {
    constexpr int EB = MOE_FP8 ? 1 : 2;
    const int e = it / P0_EXP_ITEMS, r = it % P0_EXP_ITEMS, mat = r / 512, r2 = r % 512, kb = r2 / 32, n0 = 32 * (r2 % 32);
    if (mat == 2) return P0Item{a.in[16] + (size_t)e * D * D, a.ws + WS_WD + (size_t)e * D * D * EB, D, D, 64 * kb, n0, n0};
    return P0Item{(mat == 0 ? a.in[12] : a.in[14]) + (size_t)e * D * D, a.ws + WS_WGL + (size_t)e * 2 * D * D * EB, D, D, 64 * kb, n0, (n0 >> 7) * 256 + (n0 & 127) + (mat == 1 ? 128 : 0)};
}
__device__ __forceinline__ void p0_moe_stream(const Args& a, int first, int last, int w, int nw, LAS float* scr, int lane) {
    float4 va[8], vb[8], vc[8];
    int it = first + w;
    if (it < last) p0_load(p0_moe_item(a, it), va, lane);
    if (it + nw < last) p0_load(p0_moe_item(a, it + nw), vb, lane);
    for (; it < last; it += 3 * nw) {
        if (it + 2 * nw < last) p0_load(p0_moe_item(a, it + 2 * nw), vc, lane);
        p0_finish<MOE_FP8 != 0>(p0_moe_item(a, it), va, scr, lane);
        if (it + 3 * nw < last) p0_load(p0_moe_item(a, it + 3 * nw), va, lane);
        if (it + nw < last) p0_finish<MOE_FP8 != 0>(p0_moe_item(a, it + nw), vb, scr, lane);
        if (it + 4 * nw < last) p0_load(p0_moe_item(a, it + 4 * nw), vb, lane);
        if (it + 2 * nw < last) p0_finish<MOE_FP8 != 0>(p0_moe_item(a, it + 2 * nw), vc, scr, lane);
    }
}

__global__ void __launch_bounds__(NWAVES * 64, 2) mk_fwd(Args args) {
    extern __shared__ __attribute__((aligned(16))) unsigned char lds_raw[];
    LAS unsigned char* lds = (LAS unsigned char*)lds_raw;
    volatile LAS unsigned* MISC = (volatile LAS unsigned*)(lds + MISC_OFF);
    const int tid = threadIdx.x, lane = tid & 63, wave = __builtin_amdgcn_readfirstlane(tid >> 6);
    const int G = gridDim.x; int vcu; { const int bx = blockIdx.x; vcu = (G % 8 == 0) ? (bx % 8) * (G / 8) + bx / 8 : bx; }
    unsigned char* ws = args.ws;
    unsigned* ctl = (unsigned*)(ws + WS_CTL);
    for (int u = tid; u < (LDS_BYTES - LDSCTL_OFF) / 4; u += NWAVES * 64) ((LAS unsigned*)(lds + LDSCTL_OFF))[u] = 0u;
    __syncthreads();
    const int lo = args.ph_lo, hi = args.ph_hi;
#define IN(k) (lo <= (k) && (k) < hi)
#ifndef NWK_PER_XCD
#define NWK_PER_XCD 27
#endif
    constexpr int NWK = NWK_PER_XCD;
        const bool split = (lo == 0 && hi == PH_N && G == 256);
    const bool conv = split && (vcu & 31) >= NWK;
    const int wi = split ? (vcu >> 5) * NWK + (vcu & 31) : vcu, WG = split ? 8 * NWK : G;
    XcdBarrier barW = xcd_barrier_post(ctl + CW_BAR + (2 * args.li) * XCD_BAR_WORDS, MISC + 8, (unsigned)WG, split && !conv);
    XcdBarrier barA = xcd_barrier_post(ctl + CW_BAR + (2 * args.li + 1) * XCD_BAR_WORDS, MISC + 12, (unsigned)G, true);
#define SEAM(k) do { if (IN(k) && IN((k) + 1)) { if (split && (k) < PH_GLA_C) xcd_barrier(barW); else xcd_barrier(barA); } } while (0)
    const int gw = vcu * NWAVES + wave, NGW = G * NWAVES;
    const int gww = wi * NWAVES + wave, NGWW = WG * NWAVES;
    LAS float* scr = (LAS float*)(lds + wave * 16384);
    constexpr int MOE_ITEMS_BY_WORKERS = MOE_W_ITEMS;

    if (conv) {
        const int cw = ((vcu >> 5) * (32 - NWK) + ((vcu & 31) - NWK)) * NWAVES + wave, ncw = 8 * (32 - NWK) * NWAVES;
        p0_moe_stream(args, MOE_ITEMS_BY_WORKERS, P0_MOE_ITEMS, cw, ncw, scr, lane);
    } else {
    if (IN(PH_PROLOGUE)) {
        for (int it = gww; it < P0_SMALL_ITEMS; it += NGWW) { float4 v[8]; const P0Item t = p0_small_item(args, it); p0_load(t, v, lane); p0_finish<false>(t, v, scr, lane); }
        p0_moe_stream(args, 0, split ? MOE_ITEMS_BY_WORKERS : P0_MOE_ITEMS, gww, NGWW, scr, lane);
        for (int m = gww; m < T; m += NGWW) xn_row(args.in[0], args.in[1], (bf16*)(ws + WS_XN), m, lane);
        for (int idx = (wi * NWAVES * 64) + tid; idx < NE * D; idx += WG * NWAVES * 64) { const int e = idx >> 10, k = idx & 1023; const float x = args.in[10][k * NE + e];
            const unsigned hi_ = f2bf(x); ((bf16*)(ws + WS_WRH))[idx] = (bf16)hi_; ((bf16*)(ws + WS_WRL))[idx] = (bf16)f2bf(x - __builtin_bit_cast(float, hi_ << 16)); }
    }
    SEAM(PH_PROLOGUE);
    if (IN(PH_INPROJ)) {
        pg8::Gemm g{(const bf16*)(ws + WS_XN), (const bf16*)(ws + WS_WIN), D};
        GridOrder S{DINP / 256, (T / 256) * (DINP / 256), WG, wi};
        pg8::EpiOut<0> E{(bf16*)(ws + WS_PROJ), DINP, nullptr, 0, 1.f, 1.f};
        pg8::gemm_phase<pg8::EpiOut<0>, GridOrder, true, false>(lds, g, S, E);
    }
    SEAM(PH_INPROJ);
    if (IN(PH_GLA_A)) {
        const bf16* PROJp = (const bf16*)(ws + WS_PROJ);
        {
            int U = wi; SwaRaw cur; if (U < 512) cur = swa_load(U, PROJp, tid, lane, wave);
            for (; U < 512; U += WG) { SwaRaw nxt; const bool hn = U + WG < 512; if (hn) nxt = swa_load(U + WG, PROJp, tid, lane, wave);
                swa_unit(U, cur, args.in[6], args.in[7], (bf16*)(ws + WS_CAT), lds, tid, lane, wave); if (hn) cur = nxt; }
            GlaARaw ca; if (U < 1536) ca = gla_a_load(U - 512, PROJp, args.in[3], args.in[4], lane, wave);
            for (; U < 1536; U += WG) { GlaARaw na; const bool hn = U + WG < 1536; if (hn) na = gla_a_load(U + WG - 512, PROJp, args.in[3], args.in[4], lane, wave);
                gla_a_unit(U - 512, ca, PROJp, args.in[3], args.in[4], (float*)(ws + WS_KV), (float*)(ws + WS_DECAY), (float*)(ws + WS_BLG), lds, tid, lane, wave); if (hn) ca = na; }
        }
    }
    SEAM(PH_GLA_A);
    if (IN(PH_SCAN)) {
        for (int id = (tid >> 8) * (WG * 256) + wi * 256 + (tid & 255); id < 65536; id += WG * 512) gla_scan(id, (const float*)(ws + WS_KV), (const float*)(ws + WS_DECAY), (bf16*)(ws + WS_SPREV));
    }
    SEAM(PH_SCAN);
    if (IN(PH_GLA_C)) {
        int U = wi; GlaCRaw cur; if (U < 1024) cur = gla_c_load(U, (const bf16*)(ws + WS_PROJ), (const float*)(ws + WS_BLG), (const bf16*)(ws + WS_SPREV), tid, lane, wave);
        for (; U < 1024; U += WG) { GlaCRaw nxt; const bool hn = U + WG < 1024; if (hn) nxt = gla_c_load(U + WG, (const bf16*)(ws + WS_PROJ), (const float*)(ws + WS_BLG), (const bf16*)(ws + WS_SPREV), tid, lane, wave);
            gla_c_unit(U, cur, args.in[5], (bf16*)(ws + WS_CAT), lds, tid, lane, wave); if (hn) cur = nxt; }
    }
    }
    SEAM(PH_GLA_C);
    if (IN(PH_OUTPROJ)) {
        pg8::Gemm g{(const bf16*)(ws + WS_CAT), (const bf16*)(ws + WS_WOUT), D};
        GridOrder S{D / 256, (T / 256) * (D / 256), G, vcu};
        pg8::EpiOut<0> E{(bf16*)(ws + WS_ATT), D, nullptr, 0, 1.f, 1.f};
        pg8::gemm_phase<pg8::EpiOut<0>, GridOrder, false, false>(lds, g, S, E);
    }
    SEAM(PH_OUTPROJ);
    int* cntg = (int*)ctl + CW_CNT; int* tokl = (int*)(ws + WS_TOKL);
    int* sel_e = (int*)(ws + WS_SEL); float* sel_gate = (float*)(ws + WS_SEL + 256 * 1024); int* sel_pos = (int*)(ws + WS_SEL + 512 * 1024);
    if (IN(PH_ROUTER)) {
        for (int blk = vcu; blk < T / 64; blk += G)
            router_block(blk, args.in[0], (bf16*)(ws + WS_ATT), args.in[9], (const bf16*)(ws + WS_WRH), (const bf16*)(ws + WS_WRL), args.in[11], (bf16*)(ws + WS_HN), (float*)(ws + WS_RSTD),
                         cntg, tokl, sel_e, sel_gate, sel_pos,
                         lds, tid, lane, wave);
    }
    SEAM(PH_ROUTER);
    LAS int* tab = (LAS int*)(lds + TAB_OFF);
    if (IN(PH_MOE1)) {
        if (wave == 0) { int mycnt; const int ts = lane_tstart(cntg, lane, mycnt); if (lane < NE) { tab[lane] = ts; tab[33 + lane] = mycnt; } if (lane == NE - 1) tab[32] = ts + ((mycnt + 255) >> 8); }
        __syncthreads();
        LAS int* rowtab = (LAS int*)(lds + ROWS_OFF);
        MoeOrder S{tab, rowtab, 8, tab[32], G, vcu};
        LAS int* uinfo = (LAS int*)(lds + TAB_OFF + 288);
        if (tid < ROWTABS) { int R, pn; int base = -1, nval = 0;
            if (S.map(tid, R, pn)) { const int e = MoeOrder::expert_of(tab, R), rt = R - tab[e]; base = e * T + rt * 256; nval = tab[33 + e] - rt * 256; }
            uinfo[tid * 3] = base; uinfo[tid * 3 + 1] = nval; }
        __syncthreads();
        { int tk[(ROWTABS * 256 + 511) / 512];
#pragma unroll
          for (int k = 0; k < (ROWTABS * 256 + 511) / 512; ++k) { const int idx = tid + 512 * k, j = idx >> 8, r = idx & 255; const int base = uinfo[j * 3], nval = uinfo[j * 3 + 1];
              tk[k] = (base >= 0) ? tokl[base + (r < nval ? r : 0)] : -1; }
#pragma unroll
          for (int k = 0; k < (ROWTABS * 256 + 511) / 512; ++k) { const int idx = tid + 512 * k;
              if (tk[k] >= 0) { rowtab[idx] = tk[k]; ((LAS float*)(lds + RSTD_OFF))[idx] = ((const float*)(ws + WS_RSTD))[tk[k]]; } } }
        __syncthreads();
        pg8::Gemm g{(const bf16*)(ws + WS_HN), (const bf16*)(ws + WS_WGL), MOE_FP8 ? D / 2 : D};
        pg8::EpiSwiglu E{(bf16*)(ws + WS_HID), args.in[13], args.in[15], (const LAS float*)(lds + RSTD_OFF), MOE_FP8 ? 1.f / (FP8_SA * FP8_SW) : 1.f, MOE_FP8, FP8_SH, 0};
        pg8::gemm_phase<pg8::EpiSwiglu, MoeOrder, true, true, MOE_FP8 != 0>(lds, g, S, E);
    }
    SEAM(PH_MOE1);
    if (IN(PH_MOE2)) {
        if (wave == 0) { int mycnt; const int ts = lane_tstart(cntg, lane, mycnt); if (lane < NE) { tab[lane] = ts; tab[33 + lane] = mycnt; } if (lane == NE - 1) tab[32] = ts + ((mycnt + 255) >> 8); }
        __syncthreads();
        LAS int* rowtab = (LAS int*)(lds + ROWS_OFF);
        MoeOrder S{tab, rowtab, 4, tab[32], G, vcu};
        for (int j = 0; j < ROWTABS; ++j) { int R, pn; if (!S.map(j, R, pn)) break; if (tid < 256) rowtab[j * 256 + tid] = R * 256 + tid; }
        __syncthreads();
        pg8::Gemm g{(const bf16*)(ws + WS_HID), (const bf16*)(ws + WS_WD), MOE_FP8 ? D / 2 : D};
        pg8::EpiOut<1> E{(bf16*)(ws + WS_Y), D, args.in[17], D, 1.f / (FP8_SH * FP8_SW), FP8_SY};
        pg8::gemm_phase<pg8::EpiOut<1>, MoeOrder, true, true, true>(lds, g, S, E);
    }
    SEAM(PH_MOE2);
    if (IN(PH_COMBINE)) {
        combine_rows((const bf16*)(ws + WS_ATT), args.out, (const unsigned char*)(ws + WS_Y), cntg, sel_e, sel_gate, sel_pos, args.in[18], gw, NGW, lane);
    }
#undef IN
#undef SEAM
}
extern "C" void kernel_launch(void* const* d_in, const int* in_sizes, int n_in, void* d_out, int out_size, void* d_ws, size_t ws_size, hipStream_t stream) {
    static int grid = 0;
    if (grid == 0) {
        if (n_in != 19 || out_size != T * D || ws_size < WS_END) { fprintf(stderr, "kernel_launch: unexpected shapes (n_in %d out %d ws %zu)\n", n_in, out_size, ws_size); grid = -1; return; }
        int dev = 0, cus = 0, per_cu = 0;
        if (hipGetDevice(&dev) != hipSuccess || hipDeviceGetAttribute(&cus, hipDeviceAttributeMultiprocessorCount, dev) != hipSuccess) { grid = -1; return; }
        if (hipFuncSetAttribute((const void*)mk_fwd, hipFuncAttributeMaxDynamicSharedMemorySize, LDS_BYTES) != hipSuccess) { fprintf(stderr, "kernel_launch: hipFuncSetAttribute failed\n"); grid = -1; return; }
        if (hipOccupancyMaxActiveBlocksPerMultiprocessor(&per_cu, (const void*)mk_fwd, NWAVES * 64, LDS_BYTES) != hipSuccess || per_cu < 1) fprintf(stderr, "kernel_launch: occupancy query says %d\n", per_cu);
        (void)hipGetLastError();
        grid = cus;
    }
    if (grid < 0) return;
    (void)hipMemsetAsync((unsigned char*)d_ws + WS_CTL, 0, CTL_ZERO_BYTES, stream);
    Args a{};
    for (int i = 0; i < 19; ++i) a.in[i] = (const float*)d_in[i];
    a.out = (float*)d_out; a.ws = (unsigned char*)d_ws; a.ph_lo = 0; a.ph_hi = PH_N; a.li = 0;
    hipLaunchKernelGGL(mk_fwd, dim3(grid), dim3(NWAVES * 64), LDS_BYTES, stream, a);
}
```

```cpp
#include <hip/hip_runtime.h>
#include <cstdio>
#include <cstdint>

constexpr int BATCH = 2, SEQ = 8192, T = BATCH * SEQ, D = 1024, DIN = 2320, DINP = 2560;
constexpr int NE = 32, TOPK = 4;
constexpr int C_QA = 0, C_KA = 256, C_VA = 512, C_RA = 1024, C_ZA = 1536, C_QB = 1552, C_KB = 2064, C_VB = 2192;
constexpr float EPS = 1e-5f;
constexpr int PMAX = 73728;
constexpr size_t MiB = 1u << 20;
constexpr size_t WS_CTL = 0, CTL_ZERO_BYTES = 1 * MiB;
constexpr size_t WS_TOKL = 1 * MiB;
constexpr size_t WS_SEL = 3 * MiB;
constexpr size_t WS_RSTD = 3 * MiB + 768 * 1024;
constexpr size_t WS_WRH = 11 * MiB, WS_WRL = 11 * MiB + 65536;
constexpr size_t WS_WIN = 4 * MiB;
constexpr size_t WS_WOUT = 9 * MiB;
constexpr size_t WS_WD = 16 * MiB;
constexpr size_t WS_WGL = 80 * MiB;
constexpr size_t WS_HN = 208 * MiB;
constexpr size_t WS_PROJ = 240 * MiB;
constexpr size_t WS_XN = 320 * MiB;
constexpr size_t WS_CAT = 352 * MiB;
constexpr size_t WS_ATT = 320 * MiB;
constexpr size_t WS_HID = 240 * MiB;
constexpr size_t WS_Y = 80 * MiB;
constexpr size_t WS_KV = 384 * MiB;
constexpr size_t WS_SPREV = 416 * MiB;
constexpr size_t WS_DECAY = 432 * MiB;
constexpr size_t WS_BLG = 440 * MiB;
constexpr size_t WS_END = 456 * MiB;
constexpr int CW_CNT = 0, CNT_STRIDE = 32;
constexpr int CW_BAR = 4096;

#ifndef MOE_FP8
#define MOE_FP8 1
#endif
#ifndef Y_FP8
#define Y_FP8 1
#endif
constexpr float FP8_SW = 64.f, FP8_SA = 8.f, FP8_SH = 4.f, FP8_SY = 16.f;
static_assert(MOE_FP8, "the workspace map assumes fp8 HID (72 MiB)");
typedef unsigned short bf16;
__device__ __forceinline__ float bf2f(bf16 v) { return __builtin_bit_cast(float, (unsigned)v << 16); }
typedef float f32x2_t __attribute__((ext_vector_type(2))); typedef __bf16 bf16x2_t __attribute__((ext_vector_type(2)));
__device__ __forceinline__ unsigned pk2(float lo, float hi) { const f32x2_t v = {lo, hi}; const bf16x2_t b = __builtin_convertvector(v, bf16x2_t); return __builtin_bit_cast(unsigned, b); }
__device__ __forceinline__ unsigned f2bf(float f) { return pk2(f, 0.f) & 0xffffu; }
__device__ __forceinline__ float ldf(const float* p) { return *p; }
__device__ __forceinline__ float ldf(const bf16* p) { return bf2f(*p); }

__device__ __forceinline__ float wave_sum(float v) {
#pragma unroll
    for (int o = 1; o < 64; o <<= 1) v += __shfl_xor(v, o);
    return v;
}
__device__ __forceinline__ float wave_max(float v) {
#pragma unroll
    for (int o = 1; o < 64; o <<= 1) v = fmaxf(v, __shfl_xor(v, o));
    return v;
}
__device__ __forceinline__ float logsigmoidf(float x) { return fminf(x, 0.f) - log1pf(expf(-fabsf(x))); }
__device__ __forceinline__ float logsigmoid_fast(float x) { return fminf(x, 0.f) - __logf(1.f + __expf(-fabsf(x))); }
namespace pg8 {
#define PG8_LAS __attribute__((address_space(3)))
typedef unsigned short bf16_t;
typedef short bf16x8 __attribute__((ext_vector_type(8)));
typedef float f32x4 __attribute__((ext_vector_type(4)));
typedef unsigned u32x4 __attribute__((ext_vector_type(4)));
constexpr int BM = 256, BK = 64, HALF = 128, HTB = HALF * BK * 2  , STAGE_BYTES = 8 * HTB;

__host__ __device__ __forceinline__ int lds_byte(int r, int c) { const int st = (r >> 4) * 2 + (c >> 5), rr = r & 15, cc = c & 31, ob = rr * 64 + cc * 2; return st * 1024 + (ob ^ (((ob >> 9) & 1) << 5)); }
__host__ __device__ __forceinline__ void stage_rc(int b, int& R, int& C) { const int st = b / 1024, sb = b % 1024, swz = sb ^ (((sb >> 9) & 1) << 5); R = (st >> 1) * 16 + swz / 64; C = (st & 1) * 32 + (swz % 64) / 2; }
__host__ __device__ __forceinline__ int perm32(int rho) { const int n = rho >> 4, i = rho & 15; return 8 * (i >> 2) + 4 * n + (i & 3); }

struct Unit { int pm, pn, am, bn, e, ui, skip, kind; };
struct Gemm { const bf16_t* A; const bf16_t* Bt; int K; };

typedef int v8i32 __attribute__((ext_vector_type(8)));
__device__ __forceinline__ v8i32 cat8(bf16x8 lo, bf16x8 hi) { const u32x4 a = __builtin_bit_cast(u32x4, lo), b = __builtin_bit_cast(u32x4, hi); return (v8i32){(int)a.x, (int)a.y, (int)a.z, (int)a.w, (int)b.x, (int)b.y, (int)b.z, (int)b.w}; }
__device__ __forceinline__ unsigned cvt_pk_bf16(float lo, float hi) { unsigned r; asm volatile("v_cvt_pk_bf16_f32 %0, %1, %2" : "=v"(r) : "v"(lo), "v"(hi)); return r; }

template <class Epi, class Sched, bool ALIGN_EPI, bool GATHER, bool FP8 = false, bool HOOKS = false>
__device__ __forceinline__ void gemm_phase(PG8_LAS unsigned char* lds, const Gemm g, const Sched& S, const Epi& E) {
    const int tid = threadIdx.x, wid = __builtin_amdgcn_readfirstlane(tid >> 6), lane = tid & 63, wr = wid >> 2, wc = wid & 3, fr = lane & 15, fq = lane >> 4;
    int K = g.K; asm volatile("" : "+s"(K));
    const int nt = K / BK;
    const size_t kstep = (size_t)(BK * 2);
    const size_t hstep = (size_t)HALF * K * 2;
    const size_t tstep = 2 * hstep;
    unsigned voffA0[2], voffA1[2], voffB[2];
#pragma unroll
    for (int i = 0; i < 2; ++i) { int R, C; stage_rc(tid * 16 + i * 8192, R, C); const int Rb = Epi::PERM ? ((R & ~31) + perm32(R & 31)) : R;
        voffA0[i] = (unsigned)(R * K + C) * 2u; voffA1[i] = voffA0[i] + (unsigned)hstep; voffB[i] = (unsigned)(Rb * K + C) * 2u; }
    const unsigned ldsw = (unsigned)wid * 1024u;
    const int aoff = lds_byte(wr * 64 + fr, fq * 8), boff = lds_byte(wc * 32 + fr, fq * 8);
#define PG8_SA(b, h) (((b) * 2 + (h)) * HTB)
#define PG8_SB(b, h) ((4 + (b) * 2 + (h)) * HTB)
#define PG8_STAGE(bufoff, gbase, voff) do { _Pragma("unroll") for (int _i = 0; _i < 2; ++_i) \
        __builtin_amdgcn_global_load_lds((const unsigned*)((const char*)(gbase) + (voff)[_i]), (PG8_LAS unsigned*)(lds + (bufoff) + ldsw + _i * 8192), 16, 0, 0); } while (0)
#define PG8_LDA(dst, b, h) do { _Pragma("unroll") for (int m = 0; m < 4; ++m) { if constexpr (FP8) { dst##8[m] = cat8(*(const PG8_LAS bf16x8*)(lds + PG8_SA(b, h) + aoff + m * 2048), *(const PG8_LAS bf16x8*)(lds + PG8_SA(b, h) + aoff + m * 2048 + 1024)); } \
        else { _Pragma("unroll") for (int k = 0; k < 2; ++k) dst[m][k] = *(const PG8_LAS bf16x8*)(lds + PG8_SA(b, h) + aoff + m * 2048 + k * 1024); } } } while (0)
#define PG8_LDB(dst, b, h) do { _Pragma("unroll") for (int n = 0; n < 2; ++n) { if constexpr (FP8) { dst##8[n] = cat8(*(const PG8_LAS bf16x8*)(lds + PG8_SB(b, h) + boff + n * 2048), *(const PG8_LAS bf16x8*)(lds + PG8_SB(b, h) + boff + n * 2048 + 1024)); } \
        else { _Pragma("unroll") for (int k = 0; k < 2; ++k) dst[n][k] = *(const PG8_LAS bf16x8*)(lds + PG8_SB(b, h) + boff + n * 2048 + k * 1024); } } } while (0)
#define PG8_MMA(ai, bj, At, Bt) do { __builtin_amdgcn_s_setprio(1); _Pragma("unroll") for (int m = 0; m < 4; ++m) _Pragma("unroll") for (int n = 0; n < 2; ++n) { \
        if constexpr (FP8) { acc[ai][bj][m][n] = __builtin_amdgcn_mfma_scale_f32_16x16x128_f8f6f4(Bt##8[n], At##8[m], acc[ai][bj][m][n], 0, 0, 0, 0x7f7f7f7f, 0, 0x7f7f7f7f); } \
        else { _Pragma("unroll") for (int k = 0; k < 2; ++k) acc[ai][bj][m][n] = __builtin_amdgcn_mfma_f32_16x16x32_bf16(Bt[n][k], At[m][k], acc[ai][bj][m][n], 0, 0, 0); } } \
        __builtin_amdgcn_s_setprio(0); } while (0)
#define PG8_WAIT_V(n) asm volatile("s_waitcnt vmcnt(" #n ")" ::: "memory")
#define PG8_WAIT_L(n) asm volatile("s_waitcnt lgkmcnt(" #n ")" ::: "memory")
#define PG8_BAR __builtin_amdgcn_s_barrier()
#define PG8_SCHED __builtin_amdgcn_sched_barrier(0)
#define PG8_GROWS(tab) do { _Pragma("unroll") for (int _i = 0; _i < 2; ++_i) { int R_, C_; stage_rc(tid * 16 + _i * 8192, R_, C_); \
        voffA0[_i] = (unsigned)((tab)[R_] * K + C_) * 2u; voffA1[_i] = (unsigned)((tab)[HALF + R_] * K + C_) * 2u; } } while (0)
    Unit cur, nxt; int ui = 0;
    if (!S.next(0, cur)) return;
    if constexpr (HOOKS) S.a_ready(cur);
    if constexpr (GATHER) { PG8_GROWS(S.rows(0)); }
    f32x4 acc[2][2][4][2];
#pragma unroll
    for (int a = 0; a < 2; ++a)
#pragma unroll
        for (int b = 0; b < 2; ++b)
#pragma unroll
            for (int m = 0; m < 4; ++m)
#pragma unroll
                for (int n = 0; n < 2; ++n) acc[a][b][m][n] = (f32x4){0.f, 0.f, 0.f, 0.f};
    bf16x8 At[4][2], B0[2][2], B1[2][2];
    v8i32 At8[4], B08[2], B18[2];
    const char* cA = HOOKS ? S.abase(cur) : (GATHER ? (const char*)g.A : (const char*)g.A + (size_t)cur.am * tstep); const char* cB = HOOKS ? S.bbase(cur, tstep) : (const char*)g.Bt + (size_t)cur.bn * tstep;
    PG8_STAGE(PG8_SB(0, 0), cB, voffB); PG8_STAGE(PG8_SB(0, 1), cB + hstep, voffB); PG8_STAGE(PG8_SA(0, 0), cA, voffA0); PG8_STAGE(PG8_SA(0, 1), cA, voffA1);
    if (wr == 1) PG8_BAR;
    PG8_WAIT_V(2); PG8_BAR;
    PG8_STAGE(PG8_SB(1, 0), cB + kstep, voffB); PG8_STAGE(PG8_SA(1, 0), cA + kstep, voffA0); PG8_STAGE(PG8_SB(1, 1), cB + hstep + kstep, voffB);
    PG8_WAIT_V(6); PG8_BAR;
    for (;;) {
        const bool has_next = S.next(ui + 1, nxt);
        const char* nA = HOOKS ? (has_next ? S.abase(nxt) : cA) : (GATHER ? (const char*)g.A : (has_next ? (const char*)g.A + (size_t)nxt.am * tstep : cA));
        const char* nB = has_next ? (HOOKS ? S.bbase(nxt, tstep) : (const char*)g.Bt + (size_t)nxt.bn * tstep) : cB;
#pragma unroll 1
        for (int t = 0; t < nt; t += 2) {
            const bool last = (t == nt - 2);
            const char* a1 = cA + (size_t)(t + 1) * kstep;
            const char* a2 = last ? nA : cA + (size_t)(t + 2) * kstep; const char* b2 = last ? nB : cB + (size_t)(t + 2) * kstep;
            const char* a3 = a2 + kstep; const char* b3 = b2 + kstep;
            if constexpr (HOOKS) { if (last && has_next) S.a_ready(nxt); }
            PG8_LDB(B0, 0, 0); PG8_LDB(B1, 0, 1); PG8_SCHED; PG8_LDA(At, 0, 0); PG8_STAGE(PG8_SA(1, 1), a1, voffA1);
            if constexpr (GATHER) { if (last && has_next) { PG8_GROWS(S.rows(ui + 1)); } }
            PG8_WAIT_V(8); PG8_WAIT_L(0); PG8_BAR; PG8_MMA(0, 0, At, B0); PG8_MMA(0, 1, At, B1); PG8_BAR; PG8_SCHED;
            PG8_LDA(At, 0, 1); PG8_STAGE(PG8_SB(0, 0), b2, voffB); PG8_STAGE(PG8_SB(0, 1), b2 + hstep, voffB); PG8_STAGE(PG8_SA(0, 0), a2, voffA0);
            PG8_WAIT_V(8); PG8_WAIT_L(0); PG8_BAR; PG8_MMA(1, 0, At, B0); PG8_MMA(1, 1, At, B1); PG8_BAR; PG8_SCHED;
            PG8_LDB(B0, 1, 0); PG8_LDB(B1, 1, 1); PG8_SCHED; PG8_LDA(At, 1, 0); PG8_STAGE(PG8_SA(0, 1), a2, voffA1);
            PG8_WAIT_V(8); PG8_WAIT_L(0); PG8_BAR; PG8_MMA(0, 0, At, B0); PG8_MMA(0, 1, At, B1); PG8_BAR; PG8_SCHED;
            PG8_LDA(At, 1, 1); PG8_STAGE(PG8_SB(1, 0), b3, voffB); PG8_STAGE(PG8_SB(1, 1), b3 + hstep, voffB); PG8_STAGE(PG8_SA(1, 0), a3, voffA0);
            PG8_WAIT_V(8); PG8_WAIT_L(0); PG8_BAR; PG8_MMA(1, 0, At, B0); PG8_MMA(1, 1, At, B1); PG8_BAR; PG8_SCHED;
        }
        if constexpr (ALIGN_EPI) { if (wr == 0) PG8_BAR; }
        E(acc, cur, wr, wc, fr, fq);
        if constexpr (HOOKS) S.done(cur);
        if (!has_next) break;
#pragma unroll
        for (int a = 0; a < 2; ++a)
#pragma unroll
            for (int b = 0; b < 2; ++b)
#pragma unroll
                for (int m = 0; m < 4; ++m)
#pragma unroll
                    for (int n = 0; n < 2; ++n) acc[a][b][m][n] = (f32x4){0.f, 0.f, 0.f, 0.f};
        cur = nxt; cA = nA; cB = nB; ++ui;
        if constexpr (ALIGN_EPI) { if (wr == 1) PG8_BAR; }
    }
    PG8_WAIT_V(0);
    if constexpr (!ALIGN_EPI) { if (wr == 0) PG8_BAR; }
    PG8_BAR;
#undef PG8_SA
#undef PG8_SB
#undef PG8_STAGE
#undef PG8_LDA
#undef PG8_LDB
#undef PG8_MMA
#undef PG8_WAIT_V
#undef PG8_WAIT_L
#undef PG8_BAR
#undef PG8_SCHED
#undef PG8_GROWS
}

__device__ __forceinline__ float clamp448(float v) { return fminf(fmaxf(v, -448.f), 448.f); }
__device__ __forceinline__ unsigned pack4_fp8(float a, float b, float c, float d) {
    int w = __builtin_amdgcn_cvt_pk_fp8_f32(clamp448(a), clamp448(b), 0, false); w = __builtin_amdgcn_cvt_pk_fp8_f32(clamp448(c), clamp448(d), w, true); return (unsigned)w; }
template <int MODE> struct EpiOut {
    static constexpr bool PERM = true;
    bf16_t* O; int ldc; const float* bias; int bstride; float ascale; float oscale;
    __device__ __forceinline__ void operator()(const f32x4 (&acc)[2][2][4][2], const Unit& u, int wr, int wc, int fr, int fq) const {
        const int row0 = u.pm * BM + wr * 64 + fr, col0 = u.pn * BM + wc * 32 + 8 * fq;
        f32x4 bv[2][2]; const float sc = ascale * oscale;
        if constexpr (MODE == 1) {
#pragma unroll
            for (int bj = 0; bj < 2; ++bj)
#pragma unroll
                for (int n = 0; n < 2; ++n) bv[bj][n] = *(const f32x4*)(bias + (size_t)u.e * bstride + col0 + bj * HALF + 4 * n) * oscale;
        }
#pragma unroll
        for (int ai = 0; ai < 2; ++ai)
#pragma unroll
            for (int m = 0; m < 4; ++m) {
#pragma unroll
                for (int bj = 0; bj < 2; ++bj) {
                    if constexpr (MODE == 1) { const f32x4 v0 = acc[ai][bj][m][0] * sc + bv[bj][0], v1 = acc[ai][bj][m][1] * sc + bv[bj][1];
                        typedef unsigned u32x2 __attribute__((ext_vector_type(2))); u32x2 w8; w8.x = pack4_fp8(v0[0], v0[1], v0[2], v0[3]); w8.y = pack4_fp8(v1[0], v1[1], v1[2], v1[3]);
                        *(u32x2*)((unsigned char*)O + (size_t)(row0 + ai * HALF + m * 16) * ldc + col0 + bj * HALF) = w8; }
                    else { const f32x4 v0 = acc[ai][bj][m][0], v1 = acc[ai][bj][m][1];
                        u32x4 w; w.x = cvt_pk_bf16(v0[0], v0[1]); w.y = cvt_pk_bf16(v0[2], v0[3]); w.z = cvt_pk_bf16(v1[0], v1[1]); w.w = cvt_pk_bf16(v1[2], v1[3]);
                        *(u32x4*)(O + (size_t)(row0 + ai * HALF + m * 16) * ldc + col0 + bj * HALF) = w; } } }
    }
};
struct EpiResF32 {
    static constexpr bool PERM = false;
    const float* res; float* out; int ldc;
    __device__ __forceinline__ void operator()(const f32x4 (&acc)[2][2][4][2], const Unit& u, int wr, int wc, int fr, int fq) const {
        const int row0 = u.pm * BM + wr * 64 + fr, col0 = u.pn * BM + wc * 32 + 4 * fq;
#pragma unroll
        for (int ai = 0; ai < 2; ++ai)
#pragma unroll
            for (int m = 0; m < 4; ++m) { const size_t off = (size_t)(row0 + ai * HALF + m * 16) * ldc + col0;
#pragma unroll
                for (int bj = 0; bj < 2; ++bj)
#pragma unroll
                    for (int n = 0; n < 2; ++n) { const f32x4 r = *(const f32x4*)(res + off + bj * HALF + n * 16); *(f32x4*)(out + off + bj * HALF + n * 16) = r + acc[ai][bj][m][n]; } }
    }
};
struct EpiSwiglu {
    static constexpr bool PERM = true;
    bf16_t* O; const float* bglu; const float* blin; const PG8_LAS float* rstdtab;
    float ascale; int out8; float oscale;
    int wt_tiles;
    typedef float f32x2 __attribute__((ext_vector_type(2)));
    __device__ __forceinline__ static f32x2 act2(f32x2 g, f32x2 l, float osc) {
        g = __builtin_elementwise_min(g, (f32x2){7.0f, 7.0f});
        l.x = __builtin_amdgcn_fmed3f(l.x, -7.0f, 7.0f); l.y = __builtin_amdgcn_fmed3f(l.y, -7.0f, 7.0f);
        const f32x2 t = g * -2.4554669596f;
        f32x2 e; e.x = __builtin_amdgcn_exp2f(t.x); e.y = __builtin_amdgcn_exp2f(t.y);
        e = e + 1.0f;
        f32x2 r; r.x = __builtin_amdgcn_rcpf(e.x); r.y = __builtin_amdgcn_rcpf(e.y);
        return (g * r) * (l * osc + osc);
    }
    __device__ __forceinline__ void operator()(const f32x4 (&acc)[2][2][4][2], const Unit& u, int wr, int wc, int fr, int fq) const {
        const int row0 = u.pm * BM + wr * 64 + fr, col0 = u.pn * HALF + wc * 32 + 8 * fq;
        f32x4 bg[2], bl[2];
#pragma unroll
        for (int n = 0; n < 2; ++n) { bg[n] = *(const f32x4*)(bglu + (size_t)u.e * 1024 + col0 + 4 * n); bl[n] = *(const f32x4*)(blin + (size_t)u.e * 1024 + col0 + 4 * n); }
        const float osc = out8 ? oscale : 1.0f; const bool wt = u.pm < wt_tiles;
#pragma unroll
        for (int ai = 0; ai < 2; ++ai)
#pragma unroll
            for (int m = 0; m < 4; ++m) {
                const float rs = rstdtab[u.ui * 256 + ai * HALF + wr * 64 + m * 16 + fr] * ascale;
                float h[8];
#pragma unroll
                for (int n = 0; n < 2; ++n) { const f32x4 gv = acc[ai][0][m][n] * rs + bg[n], lv = acc[ai][1][m][n] * rs + bl[n];
                    const f32x2 h0 = act2((f32x2){gv[0], gv[1]}, (f32x2){lv[0], lv[1]}, osc), h1 = act2((f32x2){gv[2], gv[3]}, (f32x2){lv[2], lv[3]}, osc);
                    h[4 * n] = h0.x; h[4 * n + 1] = h0.y; h[4 * n + 2] = h1.x; h[4 * n + 3] = h1.y; }
                if (out8) { typedef unsigned u32x2 __attribute__((ext_vector_type(2))); u32x2 w8;
                    int w0 = __builtin_amdgcn_cvt_pk_fp8_f32(h[0], h[1], 0, false); w0 = __builtin_amdgcn_cvt_pk_fp8_f32(h[2], h[3], w0, true);
                    int w1 = __builtin_amdgcn_cvt_pk_fp8_f32(h[4], h[5], 0, false); w1 = __builtin_amdgcn_cvt_pk_fp8_f32(h[6], h[7], w1, true);
                    w8.x = (unsigned)w0; w8.y = (unsigned)w1;
                    unsigned char* dp = (unsigned char*)O + (size_t)(row0 + ai * HALF + m * 16) * 1024 + col0;
                    if (wt) __hip_atomic_store((unsigned long long*)dp, ((unsigned long long)w8.y << 32) | w8.x, __ATOMIC_RELAXED, __HIP_MEMORY_SCOPE_AGENT); else *(u32x2*)dp = w8; }
                else { u32x4 w; w.x = cvt_pk_bf16(h[0], h[1]); w.y = cvt_pk_bf16(h[2], h[3]); w.z = cvt_pk_bf16(h[4], h[5]); w.w = cvt_pk_bf16(h[6], h[7]);
                    *(u32x4*)(O + (size_t)(row0 + ai * HALF + m * 16) * 1024 + col0) = w; } }
    }
};
}
#define GAS __attribute__((address_space(1)))
#define LAS __attribute__((address_space(3)))
typedef unsigned v4u __attribute__((ext_vector_type(4)));
typedef float f32x4 __attribute__((ext_vector_type(4)));
typedef short bf16x8 __attribute__((ext_vector_type(8)));
typedef GAS unsigned gu32;
typedef GAS unsigned long long gu64;
#define RLX_AGENT __ATOMIC_RELAXED, __HIP_MEMORY_SCOPE_AGENT
#define LDS_WAIT() asm volatile("s_waitcnt lgkmcnt(0)" ::: "memory")
#define VM_WAIT() asm volatile("s_waitcnt vmcnt(0)" ::: "memory")
__device__ __forceinline__ unsigned long long rt() { return __builtin_amdgcn_s_memrealtime(); }

#define XB_TMO      128
#define XB_XCNT(j)  (256  + 64 * (j))
#define XB_XSUB(j)  (1280 + 64 * (j))
#define XB_XGEN(j)  (2304 + 64 * (j))
#define XB_TOP      3328
#define XB_TOPGEN   3392
#define XCD_BAR_WORDS 3456
#define XB_SPIN_CAP (1u << 18)

__device__ __forceinline__ unsigned xb_ld(unsigned* p)              { return __hip_atomic_load(p, __ATOMIC_RELAXED, __HIP_MEMORY_SCOPE_AGENT); }
__device__ __forceinline__ unsigned xb_add(unsigned* p, unsigned v) { return __hip_atomic_fetch_add(p, v, __ATOMIC_RELAXED, __HIP_MEMORY_SCOPE_AGENT); }
__device__ __forceinline__ unsigned xb_xcc_id() { return (unsigned)__builtin_amdgcn_s_getreg((3 << 11) | 20) & 0xFu; }
#define XB_SPIN(cond, bar) do { unsigned _sp = 0; while (cond) { __builtin_amdgcn_s_sleep(1); \
    if ((++_sp & 255u) == 0u) { if (xb_ld(&(bar)[XB_TMO])) break; if (_sp > XB_SPIN_CAP) { atomicAdd(&(bar)[XB_TMO], 1u); break; } } } } while (0)

struct XcdBarrier {
    unsigned* bar; unsigned x; unsigned total;
    volatile LAS unsigned* st;
};

__device__ __forceinline__ XcdBarrier xcd_barrier_post(unsigned* bar, volatile LAS unsigned* st, unsigned total, bool member) {
    XcdBarrier b; b.bar = bar; b.x = xb_xcc_id(); b.st = st; b.total = total;
    if (member && threadIdx.x == 0) (void)xb_add(&bar[XB_XCNT(b.x)], 1u);
    return b;
}
__device__ __forceinline__ void xcd_barrier_complete(unsigned* bar, unsigned x, unsigned G, unsigned& nloc, unsigned& nx) {
    unsigned sum, cnt, mine, sp = 0u;
    for (;;) {
        sum = 0u; cnt = 0u; mine = 0u;
#pragma unroll
        for (unsigned j = 0; j < 16; ++j) { const unsigned c = xb_ld(&bar[XB_XCNT(j)]); sum += c; cnt += (c > 0u) ? 1u : 0u; mine = (j == x) ? c : mine; }
        if (sum == G) break;
        __builtin_amdgcn_s_sleep(1);
        if ((++sp & 255u) == 0u) { if (xb_ld(&bar[XB_TMO])) break; if (sp > XB_SPIN_CAP) { atomicAdd(&bar[XB_TMO], 1u); break; } }
    }
    nloc = mine > 0u ? mine : 1u; nx = cnt > 0u ? cnt : 1u;
}

__device__ __forceinline__ void xcd_barrier(const XcdBarrier& b) {
    asm volatile("s_waitcnt vmcnt(0)" ::: "memory");
    __syncthreads();
    if (threadIdx.x == 0) {
        unsigned* bar = b.bar;
        __builtin_amdgcn_s_waitcnt(0);
        unsigned nloc = b.st[0], nx = b.st[1];
        if (nloc == 0u) { xcd_barrier_complete(bar, b.x, b.total, nloc, nx); b.st[0] = nloc; b.st[1] = nx; }
        const unsigned old = xb_add(&bar[XB_XSUB(b.x)], 1u);
        const unsigned gen = old / nloc;
        if (old + 1u == (gen + 1u) * nloc) {
            __builtin_amdgcn_fence(__ATOMIC_RELEASE, "agent");
            asm volatile("s_waitcnt vmcnt(0)" ::: "memory");
            const unsigned og = xb_add(&bar[XB_TOP], 1u);
            const unsigned tg = og / nx;
            if (og + 1u == (tg + 1u) * nx) xb_add(&bar[XB_TOPGEN], 1u);
            else XB_SPIN(xb_ld(&bar[XB_TOPGEN]) == tg, bar);
            __builtin_amdgcn_fence(__ATOMIC_ACQUIRE, "agent");
            xb_add(&bar[XB_XGEN(b.x)], 1u);
            asm volatile("s_waitcnt vmcnt(0)" ::: "memory");
        } else {
            XB_SPIN(xb_ld(&bar[XB_XGEN(b.x)]) == gen, bar);
            __builtin_amdgcn_fence(__ATOMIC_ACQUIRE, "agent");
            asm volatile("s_waitcnt vmcnt(0)" ::: "memory");
        }
    }
    __syncthreads();
}
__device__ __forceinline__ int lane_tstart(const int* cnt, int lane, int& mycnt) {
    mycnt = (lane < NE) ? cnt[lane * CNT_STRIDE] : 0;
    const int tiles = (mycnt + 255) >> 8;
    int incl = tiles;
#pragma unroll
    for (int o = 1; o < 64; o <<= 1) { const int v = __shfl_up(incl, o); if (lane >= o) incl += v; }
    return incl - tiles;
}

__device__ __forceinline__ void xn_rows(const float* __restrict__ x, const float* __restrict__ g, bf16* xn, int m0, int stride, int lane) {
    float4 gg[4];
#pragma unroll
    for (int j = 0; j < 4; ++j) gg[j] = ((const float4*)g)[lane + 64 * j];
    for (int m = m0; m < T; m += 2 * stride) {
        const int rowv[2] = {m, (m + stride < T) ? m + stride : m};
        float4 v[2][4];
#pragma unroll
        for (int p = 0; p < 2; ++p) { const float4* xr = (const float4*)(x + (size_t)rowv[p] * D) + lane;
#pragma unroll
            for (int j = 0; j < 4; ++j) v[p][j] = xr[64 * j]; }
#pragma unroll
        for (int p = 0; p < 2; ++p) { float s = 0.f;
#pragma unroll
            for (int j = 0; j < 4; ++j) s += v[p][j].x * v[p][j].x + v[p][j].y * v[p][j].y + v[p][j].z * v[p][j].z + v[p][j].w * v[p][j].w;
            s = wave_sum(s);
            const float r = rsqrtf(s * (1.f / D) + EPS);
            uint2* o = (uint2*)(xn + (size_t)rowv[p] * D) + lane;
#pragma unroll
            for (int j = 0; j < 4; ++j) { uint2 w; w.x = pk2(v[p][j].x * r * gg[j].x, v[p][j].y * r * gg[j].y); w.y = pk2(v[p][j].z * r * gg[j].z, v[p][j].w * r * gg[j].w); o[64 * j] = w; } }
    }
}

__device__ __forceinline__ void combine_rows(const bf16* h16, float* out, const unsigned char* Y8, const int* cnt, const int* sel_e, const float* sel_gate,
                                             const int* sel_pos, const float* __restrict__ g, int m0, int stride, int lane) {
    int mycnt; const int ts = lane_tstart(cnt, lane, mycnt);
    for (int m = m0; m < T; m += 2 * stride) {
        const int rowv[2] = {m, (m + stride < T) ? m + stride : m};
        uint2 aw[2][4]; unsigned yw[2][4][4]; float gs[2][4]; float4 v[2][4];
#pragma unroll
        for (int p = 0; p < 2; ++p) { const int row = rowv[p];
            const uint2* ar = (const uint2*)(h16 + (size_t)row * D) + lane;
#pragma unroll
            for (int j = 0; j < 4; ++j) aw[p][j] = ar[64 * j];
#pragma unroll
            for (int k = 0; k < 4; ++k) { const int e = sel_e[row * 4 + k]; const int pos = sel_pos[row * 4 + k]; gs[p][k] = sel_gate[row * 4 + k] * (1.f / FP8_SY);
                const unsigned* yr = (const unsigned*)(Y8 + (size_t)(256 * __shfl(ts, e) + pos) * D) + lane;
#pragma unroll
                for (int j = 0; j < 4; ++j) yw[p][k][j] = yr[64 * j]; } }
#pragma unroll
        for (int p = 0; p < 2; ++p) { const int row = rowv[p];
            float s = 0.f;
#pragma unroll
            for (int j = 0; j < 4; ++j) { float4 a;
                a.x = __builtin_bit_cast(float, aw[p][j].x << 16); a.y = __builtin_bit_cast(float, aw[p][j].x & 0xffff0000u); a.z = __builtin_bit_cast(float, aw[p][j].y << 16); a.w = __builtin_bit_cast(float, aw[p][j].y & 0xffff0000u);
#pragma unroll
                for (int k = 0; k < 4; ++k) { const f32x2_t lo2 = __builtin_amdgcn_cvt_pk_f32_fp8((int)yw[p][k][j], false), hi2 = __builtin_amdgcn_cvt_pk_f32_fp8((int)yw[p][k][j], true);
                    a.x += gs[p][k] * lo2[0]; a.y += gs[p][k] * lo2[1]; a.z += gs[p][k] * hi2[0]; a.w += gs[p][k] * hi2[1]; }
                s += a.x * a.x + a.y * a.y + a.z * a.z + a.w * a.w; v[p][j] = a; }
            s = wave_sum(s);
            const float r = rsqrtf(s * (1.f / D) + EPS);
            float4* orow = (float4*)(out + (size_t)row * D) + lane;
#pragma unroll
            for (int j = 0; j < 4; ++j) { const float4 gg = ((const float4*)g)[lane + 64 * j];
                float4 w; w.x = v[p][j].x * r * gg.x; w.y = v[p][j].y * r * gg.y; w.z = v[p][j].z * r * gg.z; w.w = v[p][j].w * r * gg.w; orow[64 * j] = w; } }
    }
}

typedef float f32x16 __attribute__((ext_vector_type(16)));
typedef short s16x8 __attribute__((ext_vector_type(8)));
typedef unsigned v2u __attribute__((ext_vector_type(2)));
#define MFMA32(a, b, c) __builtin_amdgcn_mfma_f32_32x32x16_bf16((a), (b), (c), 0, 0, 0)
__device__ __forceinline__ int mrow(int reg, int hh) { return (reg & 3) + 8 * (reg >> 2) + 4 * hh; }
__device__ __forceinline__ v4u pack8(const float (&f)[8]) { v4u w; w.x = pk2(f[0], f[1]); w.y = pk2(f[2], f[3]); w.z = pk2(f[4], f[5]); w.w = pk2(f[6], f[7]); return w; }
__device__ __forceinline__ float bflo(unsigned w) { return __builtin_bit_cast(float, w << 16); }
__device__ __forceinline__ float bfhi(unsigned w) { return __builtin_bit_cast(float, w & 0xffff0000u); }

__device__ __forceinline__ void gla_decay(unsigned zc, const float (&w)[16], float ba, int lane, int wave, LAS unsigned* zl, LAS float* seg, float (&bcs)[8], float& blast) {
    zl[lane] = zc;
    float run = 0.f;
#pragma unroll
    for (int jj = 0; jj < 8; ++jj) {
        const v4u z0 = *(const LAS v4u*)(zl + jj * 8), z1 = *(const LAS v4u*)(zl + jj * 8 + 4);
        float a = ba;
        a += w[0] * bflo(z0.x) + w[1] * bfhi(z0.x) + w[2] * bflo(z0.y) + w[3] * bfhi(z0.y) + w[4] * bflo(z0.z) + w[5] * bfhi(z0.z) + w[6] * bflo(z0.w) + w[7] * bfhi(z0.w);
        a += w[8] * bflo(z1.x) + w[9] * bfhi(z1.x) + w[10] * bflo(z1.y) + w[11] * bfhi(z1.y) + w[12] * bflo(z1.z) + w[13] * bfhi(z1.z) + w[14] * bflo(z1.w) + w[15] * bfhi(z1.w);
        run += logsigmoid_fast(a) * (1.f / 16.f);
        bcs[jj] = run;
    }
    seg[wave * 64 + lane] = run;
    __syncthreads();
    float off = 0.f, tot = 0.f;
#pragma unroll
    for (int w8 = 0; w8 < 8; ++w8) { const float s = seg[w8 * 64 + lane]; tot += s; off += (w8 < wave) ? s : 0.f; }
#pragma unroll
    for (int jj = 0; jj < 8; ++jj) bcs[jj] += off;
    blast = tot;
}
struct T16 { v4u x0, x1; };
__device__ __forceinline__ T16 load_T16(const bf16* src, size_t ld, int lane, int wave) { const v4u* sp = (const v4u*)(src + (size_t)lane * ld + wave * 16); T16 t; t.x0 = sp[0]; t.x1 = sp[1]; return t; }
__device__ __forceinline__ void store_T16(const T16& t, LAS bf16* dst, int lane, int wave) {
    const unsigned w[8] = {t.x0.x, t.x0.y, t.x0.z, t.x0.w, t.x1.x, t.x1.y, t.x1.z, t.x1.w};
    LAS bf16* d = dst + (wave * 16) * 72 + lane;
#pragma unroll
    for (int i = 0; i < 8; ++i) { d[(2 * i) * 72] = (bf16)(w[i] & 0xffffu); d[(2 * i + 1) * 72] = (bf16)(w[i] >> 16); }
}
__device__ __forceinline__ void gla_publish(LAS float* BL, LAS float* BLAST, const float (&bcs)[8], float blast, int lane, int wave) {
#pragma unroll
    for (int jj = 0; jj < 8; ++jj) BL[(wave * 8 + jj) * 68 + lane] = bcs[jj];
    if (wave == 0) BLAST[lane] = blast;
}

struct GlaARaw { v4u kr; T16 vraw; unsigned zc; float wup[16]; float ba; };
__device__ __forceinline__ GlaARaw gla_a_load(int u, const bf16* PROJ, const float* __restrict__ wup, const float* __restrict__ balpha, int lane, int wave) {
    const int bh = u >> 7, c = u & 127, b = bh >> 2, h = bh & 3;
    const bf16* prow0 = PROJ + (size_t)(b * SEQ + c * 64) * DINP;
    GlaARaw w; w.kr = *(const v4u*)(prow0 + (size_t)lane * DINP + C_KA + h * 64 + wave * 8); w.vraw = load_T16(prow0 + C_VA + h * 128, DINP, lane, wave);
    w.zc = *(const unsigned*)(prow0 + (size_t)(wave * 8 + (lane >> 3)) * DINP + C_ZA + 2 * (lane & 7));
#pragma unroll
    for (int r = 0; r < 16; ++r) w.wup[r] = wup[r * 256 + h * 64 + lane];
    w.ba = balpha[h * 64 + lane];
    return w;
}
__device__ __forceinline__ void gla_a_unit(int u, const GlaARaw& w, const bf16* PROJ, const float* __restrict__ wup, const float* __restrict__ balpha, float* KV, float* DECAY, float* BLG,
                                           LAS unsigned char* lds, int tid, int lane, int wave) {
    const int bh = u >> 7, c = u & 127, b = bh >> 2, h = bh & 3;
    const bf16* prow0 = PROJ + (size_t)(b * SEQ + c * 64) * DINP;
    LAS bf16* KT = (LAS bf16*)lds; LAS bf16* VT = (LAS bf16*)(lds + 9216); LAS float* seg = (LAS float*)(lds + 27648);
    LAS float* BL = (LAS float*)(lds + 29696); LAS float* BLAST = (LAS float*)(lds + 47104);
    const v4u kr = w.kr; const T16 vraw = w.vraw;
    float bcs[8], blast;
    gla_decay(w.zc, w.wup, w.ba, lane, wave, (LAS unsigned*)(lds + 47360 + wave * 256), seg, bcs, blast);
    gla_publish(BL, BLAST, bcs, blast, lane, wave);
    if (wave == 0) DECAY[u * 64 + lane] = __expf(blast);
    { float* bg = BLG + (size_t)u * 4096 + (wave * 8) * 64 + lane;
#pragma unroll
      for (int jj = 0; jj < 8; ++jj) bg[jj * 64] = bcs[jj]; }
    __syncthreads();
    {
      const f32x4 b0 = *(const LAS f32x4*)(BL + lane * 68 + wave * 8), b1 = *(const LAS f32x4*)(BL + lane * 68 + wave * 8 + 4);
      const f32x4 l0 = *(const LAS f32x4*)(BLAST + wave * 8), l1 = *(const LAS f32x4*)(BLAST + wave * 8 + 4);
      const unsigned kw[4] = {kr.x, kr.y, kr.z, kr.w};
      LAS bf16* d = KT + (wave * 8) * 72 + lane;
#pragma unroll
      for (int i = 0; i < 4; ++i) { const float e0 = (i < 2 ? l0[2 * i] - b0[2 * i] : l1[2 * i - 4] - b1[2 * i - 4]), e1 = (i < 2 ? l0[2 * i + 1] - b0[2 * i + 1] : l1[2 * i - 3] - b1[2 * i - 3]);
          d[(2 * i) * 72] = (bf16)f2bf(bflo(kw[i]) * __expf(e0)); d[(2 * i + 1) * 72] = (bf16)f2bf(bfhi(kw[i]) * __expf(e1)); } }
    store_T16(vraw, VT, lane, wave);
    __syncthreads();
    const int r = lane & 31, hh = lane >> 5, dt = wave & 1, vt = wave >> 1;
    f32x16 acc = {};
#pragma unroll
    for (int ks = 0; ks < 4; ++ks) {
        const s16x8 a = *(const LAS s16x8*)(KT + (dt * 32 + r) * 72 + ks * 16 + 8 * hh);
        const s16x8 bb = *(const LAS s16x8*)(VT + (vt * 32 + r) * 72 + ks * 16 + 8 * hh);
        acc = MFMA32(a, bb, acc);
    }
    float* kvp = KV + (size_t)u * 8192 + vt * 32 + r;
#pragma unroll
    for (int reg = 0; reg < 16; ++reg) kvp[(dt * 32 + mrow(reg, hh)) * 128] = acc[reg];
    __syncthreads();
}
__device__ __forceinline__ void gla_scan(int id, const float* KV, const float* DECAY, bf16* SPREV) {
    const int bh = id >> 13, dv = id & 8191, d = dv >> 7;
    float S = 0.f;
    const size_t base = (size_t)bh * 128 * 8192 + dv;
#pragma unroll 32
    for (int c = 0; c < 128; ++c) {
        const float kv = KV[base + (size_t)c * 8192];
        const float dec = DECAY[(bh * 128 + c) * 64 + d];
        SPREV[base + (size_t)c * 8192] = (bf16)f2bf(S);
        S = dec * S + kv;
    }
}
struct GlaCRaw { v4u qr, kr; T16 vraw, sraw; v4u rg0, rg1; f32x4 b0, b1; };
__device__ __forceinline__ GlaCRaw gla_c_load(int u, const bf16* PROJ, const float* BLG, const bf16* SPREV, int tid, int lane, int wave) {
    const int bh = u >> 7, c = u & 127, b = bh >> 2, h = bh & 3;
    const size_t row0 = (size_t)b * SEQ + c * 64;
    const bf16* prow0 = PROJ + row0 * DINP;
    GlaCRaw w;
    w.qr = *(const v4u*)(prow0 + (size_t)lane * DINP + C_QA + h * 64 + wave * 8); w.kr = *(const v4u*)(prow0 + (size_t)lane * DINP + C_KA + h * 64 + wave * 8);
    w.vraw = load_T16(prow0 + C_VA + h * 128, DINP, lane, wave); w.sraw = load_T16(SPREV + (size_t)u * 8192, 128, lane, wave);
    const v4u* rp_ = (const v4u*)(PROJ + (row0 + (tid >> 3)) * DINP + C_RA + h * 128 + (tid & 7) * 16);
    w.rg0 = rp_[0]; w.rg1 = rp_[1];
    w.b0 = *(const f32x4*)(BLG + (size_t)u * 4096 + lane * 64 + wave * 8); w.b1 = *(const f32x4*)(BLG + (size_t)u * 4096 + lane * 64 + wave * 8 + 4);
    return w;
}
__device__ __forceinline__ void gla_c_unit(int u, const GlaCRaw& w, const float* __restrict__ gnorm, bf16* CAT, LAS unsigned char* lds, int tid, int lane, int wave) {
    const int bh = u >> 7, c = u & 127, b = bh >> 2, h = bh & 3;
    const size_t row0 = (size_t)b * SEQ + c * 64;
    LAS bf16* QE = (LAS bf16*)lds; LAS bf16* KE = (LAS bf16*)(lds + 9216); LAS bf16* AM = (LAS bf16*)(lds + 18432);
    LAS bf16* VT = (LAS bf16*)(lds + 27648); LAS bf16* ST = (LAS bf16*)(lds + 46080); LAS float* OB = (LAS float*)(lds + 64512);
    const v4u qr = w.qr, kr = w.kr, rg0 = w.rg0, rg1 = w.rg1; const f32x4 b0 = w.b0, b1 = w.b1; const T16 vraw = w.vraw, sraw = w.sraw;
    {
      const unsigned qw[4] = {qr.x, qr.y, qr.z, qr.w}, kw[4] = {kr.x, kr.y, kr.z, kr.w};
      float qe[8], ke[8];
#pragma unroll
      for (int i = 0; i < 4; ++i) { const float ba = (i < 2 ? b0[2 * i] : b1[2 * i - 4]), bb = (i < 2 ? b0[2 * i + 1] : b1[2 * i - 3]);
          const float ea = __expf(ba), eb = __expf(bb);
          qe[2 * i] = bflo(qw[i]) * 0.125f * ea; qe[2 * i + 1] = bfhi(qw[i]) * 0.125f * eb;
          ke[2 * i] = bflo(kw[i]) * __builtin_amdgcn_rcpf(ea); ke[2 * i + 1] = bfhi(kw[i]) * __builtin_amdgcn_rcpf(eb); }
      *(LAS v4u*)(QE + lane * 72 + wave * 8) = pack8(qe); *(LAS v4u*)(KE + lane * 72 + wave * 8) = pack8(ke); }
    store_T16(vraw, VT, lane, wave);
    store_T16(sraw, ST, lane, wave);
    __syncthreads();
    const int r = lane & 31, hh = lane >> 5;
    if (wave < 3) {
        const int it = wave ? 1 : 0, jt = wave == 2 ? 1 : 0;
        f32x16 acc = {};
#pragma unroll
        for (int ks = 0; ks < 4; ++ks) {
            const s16x8 a = *(const LAS s16x8*)(QE + (it * 32 + r) * 72 + ks * 16 + 8 * hh);
            const s16x8 bb = *(const LAS s16x8*)(KE + (jt * 32 + r) * 72 + ks * 16 + 8 * hh);
            acc = MFMA32(a, bb, acc);
        }
        const int j = jt * 32 + r;
#pragma unroll
        for (int reg = 0; reg < 16; ++reg) { const int i = it * 32 + mrow(reg, hh); AM[i * 72 + j] = (bf16)f2bf(j <= i ? acc[reg] : 0.f); }
    } else if (wave == 3) {
#pragma unroll
        for (int reg = 0; reg < 16; ++reg) AM[mrow(reg, hh) * 72 + 32 + r] = 0;
    }
    __syncthreads();
    { const int it = wave & 1, vt = wave >> 1;
      f32x16 acc = {};
#pragma unroll
      for (int ks = 0; ks < 4; ++ks) {
          const s16x8 a = *(const LAS s16x8*)(AM + (it * 32 + r) * 72 + ks * 16 + 8 * hh);
          const s16x8 bb = *(const LAS s16x8*)(VT + (vt * 32 + r) * 72 + ks * 16 + 8 * hh);
          acc = MFMA32(a, bb, acc);
      }
#pragma unroll
      for (int ks = 0; ks < 4; ++ks) {
          const s16x8 a = *(const LAS s16x8*)(QE + (it * 32 + r) * 72 + ks * 16 + 8 * hh);
          const s16x8 bb = *(const LAS s16x8*)(ST + (vt * 32 + r) * 72 + ks * 16 + 8 * hh);
          acc = MFMA32(a, bb, acc);
      }
#pragma unroll
      for (int reg = 0; reg < 16; ++reg) OB[(it * 32 + mrow(reg, hh)) * 132 + vt * 32 + r] = acc[reg]; }
    __syncthreads();
    { const int i = tid >> 3, s8 = tid & 7;
      float o[16]; float ss = 0.f;
#pragma unroll
      for (int q4 = 0; q4 < 4; ++q4) { const f32x4 t4 = *(const LAS f32x4*)(OB + i * 132 + s8 * 16 + q4 * 4); o[4 * q4] = t4[0]; o[4 * q4 + 1] = t4[1]; o[4 * q4 + 2] = t4[2]; o[4 * q4 + 3] = t4[3]; }
#pragma unroll
      for (int q = 0; q < 16; ++q) ss += o[q] * o[q];
      ss += __shfl_xor(ss, 1); ss += __shfl_xor(ss, 2); ss += __shfl_xor(ss, 4);
      const float rstd = rsqrtf(ss * (1.f / 128.f) + EPS);
      const unsigned rw[8] = {rg0.x, rg0.y, rg0.z, rg0.w, rg1.x, rg1.y, rg1.z, rg1.w};
      float res[16];
#pragma unroll
      for (int q = 0; q < 8; ++q) { const float ra = bflo(rw[q]), rb = bfhi(rw[q]);
          res[2 * q] = o[2 * q] * rstd * gnorm[s8 * 16 + 2 * q] * (ra * __builtin_amdgcn_rcpf(1.f + __builtin_amdgcn_exp2f(-1.4426950408889634f * ra)));
          res[2 * q + 1] = o[2 * q + 1] * rstd * gnorm[s8 * 16 + 2 * q + 1] * (rb * __builtin_amdgcn_rcpf(1.f + __builtin_amdgcn_exp2f(-1.4426950408889634f * rb))); }
      uint4 w0, w1;
      w0.x = pk2(res[0], res[1]); w0.y = pk2(res[2], res[3]); w0.z = pk2(res[4], res[5]); w0.w = pk2(res[6], res[7]);
      w1.x = pk2(res[8], res[9]); w1.y = pk2(res[10], res[11]); w1.z = pk2(res[12], res[13]); w1.w = pk2(res[14], res[15]);
      uint4* op = (uint4*)(CAT + (row0 + i) * D + h * 128 + s8 * 16);
      op[0] = w0; op[1] = w1; }
    __syncthreads();
}

struct SwaRaw { v4u k[3], v[3]; s16x8 qf[4]; };
__device__ __forceinline__ SwaRaw swa_load(int s, const bf16* PROJ, int tid, int lane, int wave) {
    const int b = s >> 8, kvh = (s >> 7) & 1, qt = s & 127, q0 = qt * 64;
    const size_t rowb = (size_t)b * SEQ;
    SwaRaw w;
#pragma unroll
    for (int i = 0; i < 3; ++i) { const int id = tid + 512 * i, kk = id >> 3, ch = id & 7; int tok = q0 - 128 + kk; tok = tok < 0 ? 0 : tok;
        w.k[i] = *(const v4u*)(PROJ + (rowb + tok) * DINP + C_KB + kvh * 64 + ch * 8); }
#pragma unroll
    for (int g3 = 0; g3 < 3; ++g3) { int tok = q0 - 128 + 64 * g3 + lane; tok = tok < 0 ? 0 : tok;
        w.v[g3] = *(const v4u*)(PROJ + (rowb + tok) * DINP + C_VB + kvh * 64 + wave * 8); }
    const int r = lane & 31, hh = lane >> 5, g = wave >> 1, half = wave & 1, hq = kvh * 4 + g;
    const bf16* qp = PROJ + (rowb + q0 + half * 32 + r) * DINP + C_QB + hq * 64 + 8 * hh;
#pragma unroll
    for (int ks = 0; ks < 4; ++ks) w.qf[ks] = *(const s16x8*)(qp + ks * 16);
    return w;
}
__device__ __forceinline__ void swa_unit(int s, const SwaRaw& w, const float* __restrict__ sinks, const float* __restrict__ gnorm, bf16* CAT,
                                         LAS unsigned char* lds, int tid, int lane, int wave) {
    const int b = s >> 8, kvh = (s >> 7) & 1, qt = s & 127, q0 = qt * 64;
    const size_t rowb = (size_t)b * SEQ;
    LAS bf16* KS = (LAS bf16*)lds; LAS bf16* VT = (LAS bf16*)(lds + 27648); LAS bf16* STG = (LAS bf16*)(lds + 53248 + wave * 4608);
#pragma unroll
    for (int i = 0; i < 3; ++i) { const int id = tid + 512 * i, kk = id >> 3, ch = id & 7; *(LAS v4u*)(KS + kk * 72 + ch * 8) = w.k[i]; }
#pragma unroll
    for (int g3 = 0; g3 < 3; ++g3) { const int kk = 64 * g3 + lane; const unsigned wv[4] = {w.v[g3].x, w.v[g3].y, w.v[g3].z, w.v[g3].w};
        LAS bf16* d = VT + (wave * 8) * 200 + kk;
#pragma unroll
        for (int i = 0; i < 4; ++i) { d[(2 * i) * 200] = (bf16)(wv[i] & 0xffffu); d[(2 * i + 1) * 200] = (bf16)(wv[i] >> 16); } }
    const int r = lane & 31, hh = lane >> 5, g = wave >> 1, half = wave & 1, hq = kvh * 4 + g;
    s16x8 qf[4];
#pragma unroll
    for (int ks = 0; ks < 4; ++ks) qf[ks] = w.qf[ks];
    __syncthreads();
    const float L2E = 1.4426950408889634f;
    const float slope2 = exp2f(-(float)(hq + 1)) * L2E, sink2 = sinks[hq] * L2E;
    const int rl = r - 4 * hh, kmin = 128 - q0 - 32 * half - 4 * hh;
    const float fbl = slope2 * (float)rl;
    float m = sink2;
    f32x16 sc[5];
#pragma unroll
    for (int blk = 0; blk < 5; ++blk) { sc[blk] = (f32x16){};
#pragma unroll
        for (int ks = 0; ks < 4; ++ks) { const s16x8 a = *(const LAS s16x8*)(KS + (32 * (half + blk) + r) * 72 + ks * 16 + 8 * hh); sc[blk] = MFMA32(a, qf[ks], sc[blk]); }
        if (blk >= 1 && blk <= 3 && q0 >= 128) {
#pragma unroll
            for (int reg = 0; reg < 16; ++reg) { const int c1 = 128 - (32 * blk + (reg & 3) + 8 * (reg >> 2));
                const float v = fmaf(sc[blk][reg], 0.125f * L2E, -(fbl + slope2 * (float)c1));
                sc[blk][reg] = v; m = fmaxf(m, v); }
        } else {
#pragma unroll
            for (int reg = 0; reg < 16; ++reg) { const int c2 = 32 * blk + (reg & 3) + 8 * (reg >> 2), c1 = 128 - c2;
                const bool valid = ((unsigned)(rl + c1) < 128u) && (c2 >= kmin);
                const float v = valid ? fmaf(sc[blk][reg], 0.125f * L2E, -(fbl + slope2 * (float)c1)) : -INFINITY;
                sc[blk][reg] = v; m = fmaxf(m, v); }
        }
        __builtin_amdgcn_sched_barrier(0);
    }
    m = fmaxf(m, __shfl_xor(m, 32));
    float l = 0.f;
    f32x16 o[2]; o[0] = (f32x16){}; o[1] = (f32x16){};
#pragma unroll
    for (int blk = 0; blk < 5; ++blk) {
        float p[16];
#pragma unroll
        for (int reg = 0; reg < 16; ++reg) { p[reg] = __builtin_amdgcn_exp2f(sc[blk][reg] - m); l += p[reg]; }
#pragma unroll
        for (int s2 = 0; s2 < 2; ++s2) {
            v4u pw; pw.x = pk2(p[8 * s2], p[8 * s2 + 1]); pw.y = pk2(p[8 * s2 + 2], p[8 * s2 + 3]); pw.z = pk2(p[8 * s2 + 4], p[8 * s2 + 5]); pw.w = pk2(p[8 * s2 + 6], p[8 * s2 + 7]);
            const s16x8 pf = __builtin_bit_cast(s16x8, pw);
            const int base = 32 * (half + blk) + 16 * s2 + 4 * hh;
#pragma unroll
            for (int db = 0; db < 2; ++db) {
                const v2u lo = *(const LAS v2u*)(VT + (db * 32 + r) * 200 + base), hi = *(const LAS v2u*)(VT + (db * 32 + r) * 200 + base + 8);
                v4u aw; aw.x = lo.x; aw.y = lo.y; aw.z = hi.x; aw.w = hi.y;
                o[db] = MFMA32(__builtin_bit_cast(s16x8, aw), pf, o[db]);
            }
        }
        __builtin_amdgcn_sched_barrier(0);
    }
    l += __shfl_xor(l, 32);
    l += __builtin_amdgcn_exp2f(sink2 - m);
    const float inv_l = 1.f / l;
    float ss = 0.f;
#pragma unroll
    for (int db = 0; db < 2; ++db)
#pragma unroll
        for (int reg = 0; reg < 16; ++reg) { o[db][reg] *= inv_l; ss += o[db][reg] * o[db][reg]; }
    ss += __shfl_xor(ss, 32);
    const float rstd = rsqrtf(ss * (1.f / 64.f) + EPS);
#pragma unroll
    for (int db = 0; db < 2; ++db)
#pragma unroll
        for (int rq = 0; rq < 4; ++rq) { const float4 gg = *(const float4*)(gnorm + db * 32 + 8 * rq + 4 * hh);
            const int dv = db * 32 + 8 * rq + 4 * hh;
            STG[r * 72 + dv + 0] = (bf16)f2bf(o[db][4 * rq + 0] * rstd * gg.x); STG[r * 72 + dv + 1] = (bf16)f2bf(o[db][4 * rq + 1] * rstd * gg.y);
            STG[r * 72 + dv + 2] = (bf16)f2bf(o[db][4 * rq + 2] * rstd * gg.z); STG[r * 72 + dv + 3] = (bf16)f2bf(o[db][4 * rq + 3] * rstd * gg.w); }
    asm volatile("s_waitcnt lgkmcnt(0)" ::: "memory");
#pragma unroll
    for (int it = 0; it < 4; ++it) { const int q = (lane >> 3) + 8 * it, ch = lane & 7;
        const v4u v = *(const LAS v4u*)(STG + q * 72 + ch * 8);
        *(v4u*)(CAT + (rowb + q0 + half * 32 + q) * D + 512 + hq * 64 + ch * 8) = v; }
    __syncthreads();
}

__device__ __forceinline__ void router_block(int blk, const float* __restrict__ X, bf16* ATT  , const float* __restrict__ g2, const bf16* WRH, const bf16* WRL, const float* __restrict__ br,
                                             bf16* HN, float* RSTD, int* cnt, int* tok_list, int* sel_e, float* sel_gate, int* sel_pos,
                                             LAS unsigned char* lds, int tid, int lane, int wave) {
    LAS unsigned char* reg_w = lds + wave * 16384;
    const int r = lane & 31, hh = lane >> 5, t = wave >> 2, q = wave & 3;
    const size_t row0 = (size_t)blk * 64 + t * 32;
    const int c4 = 4 * r;
    f32x16 acc = {};
    float sq[16];
#pragma unroll
    for (int i = 0; i < 16; ++i) sq[i] = 0.f;
#pragma unroll 1
    for (int sc = 0; sc < 2; ++sc) {
        const int kb = q * 256 + sc * 128;
        const float4 gg = *(const float4*)(g2 + kb + c4);
#pragma unroll
        for (int i = 0; i < 16; ++i) {
            const int rw = 2 * i + hh; const size_t grow = row0 + rw;
            float4 h = *(const float4*)(X + grow * D + kb + c4);
            const uint2 aw = *(const uint2*)(ATT + grow * D + kb + c4);
            h.x += bflo(aw.x); h.y += bfhi(aw.x); h.z += bflo(aw.y); h.w += bfhi(aw.y);
            sq[i] += h.x * h.x + h.y * h.y + h.z * h.z + h.w * h.w;
            { uint2 hw; hw.x = pk2(h.x, h.y); hw.y = pk2(h.z, h.w); *(uint2*)(ATT + grow * D + kb + c4) = hw; }
            const float x0 = h.x * gg.x, x1 = h.y * gg.y, x2 = h.z * gg.z, x3 = h.w * gg.w;
            v2u vh, vl; vh.x = pk2(x0, x1); vh.y = pk2(x2, x3);
            vl.x = pk2(x0 - bflo(vh.x), x1 - bfhi(vh.x)); vl.y = pk2(x2 - bflo(vh.y), x3 - bfhi(vh.y));
            const int off = rw * 256 + (((r >> 1) ^ (rw & 15)) << 4) + ((r & 1) << 3);
            *(LAS v2u*)(reg_w + off) = vh; *(LAS v2u*)(reg_w + 8192 + off) = vl;
#if MOE_FP8
            *(unsigned*)((unsigned char*)HN + grow * D + kb + c4) = pg8::pack4_fp8(x0 * FP8_SA, x1 * FP8_SA, x2 * FP8_SA, x3 * FP8_SA);
#else
            *(v2u*)(HN + grow * D + kb + c4) = vh;
#endif
        }
#pragma unroll
        for (int ks = 0; ks < 8; ++ks) {
            const int off = r * 256 + (((2 * ks + hh) ^ (r & 15)) << 4);
            const s16x8 fh = *(const LAS s16x8*)(reg_w + off), fl = *(const LAS s16x8*)(reg_w + 8192 + off);
            const s16x8 wh = *(const s16x8*)(WRH + (size_t)r * D + kb + ks * 16 + 8 * hh), wl = *(const s16x8*)(WRL + (size_t)r * D + kb + ks * 16 + 8 * hh);
            acc = MFMA32(fh, wh, acc); acc = MFMA32(fh, wl, acc); acc = MFMA32(fl, wh, acc);
        }
    }
    { const bool b4 = r & 16, b3 = r & 8, b2 = r & 4, b1 = r & 2;
      float s8[8], s4[4], s2[2], s1;
#pragma unroll
      for (int j = 0; j < 8; ++j) s8[j] = (b4 ? sq[j + 8] : sq[j]) + __shfl_xor(b4 ? sq[j] : sq[j + 8], 16);
#pragma unroll
      for (int j = 0; j < 4; ++j) s4[j] = (b3 ? s8[j + 4] : s8[j]) + __shfl_xor(b3 ? s8[j] : s8[j + 4], 8);
#pragma unroll
      for (int j = 0; j < 2; ++j) s2[j] = (b2 ? s4[j + 2] : s4[j]) + __shfl_xor(b2 ? s4[j] : s4[j + 2], 4);
      s1 = (b1 ? s2[1] : s2[0]) + __shfl_xor(b1 ? s2[0] : s2[1], 2);
      s1 += __shfl_xor(s1, 1);
      const int i = (b4 ? 8 : 0) + (b3 ? 4 : 0) + (b2 ? 2 : 0) + (b1 ? 1 : 0);
      LAS float* SQw = (LAS float*)(reg_w + 4096);
      if (!(r & 1)) SQw[2 * i + hh] = s1; }
    { LAS float* PARTw = (LAS float*)reg_w;
#pragma unroll
      for (int reg = 0; reg < 16; ++reg) PARTw[mrow(reg, hh) * 32 + r] = acc[reg]; }
    __syncthreads();
#define PART_AT(w_, m_, e_) (*(const LAS float*)(lds + (w_) * 16384 + ((m_) * 32 + (e_)) * 4))
#define SQ_AT(w_, m_) (*(const LAS float*)(lds + (w_) * 16384 + 4096 + (m_) * 4))
    LAS int* lcnt = (LAS int*)(lds + 8192); LAS int* lbase = lcnt + 32;
    if (tid < 32) lcnt[tid] = 0;
    __syncthreads();
    int s_ex[4], s_lp[4]; float s_gt[4];
#pragma unroll
    for (int it = 0; it < 4; ++it) {
        const int rl = wave * 8 + it * 2 + hh, tt = rl >> 5, m = rl & 31, e = r;
        float lg = 0.f, ss = 0.f;
#pragma unroll
        for (int qq = 0; qq < 4; ++qq) { lg += PART_AT(tt * 4 + qq, m, e); ss += SQ_AT(tt * 4 + qq, m); }
        const float rstd = rsqrtf(ss * (1.f / D) + EPS);
        float cur = lg * rstd + br[e];
        float tv[4]; int ti[4];
#pragma unroll
        for (int k = 0; k < 4; ++k) {
            float mx = cur;
#pragma unroll
            for (int o = 1; o < 32; o <<= 1) mx = fmaxf(mx, __shfl_xor(mx, o));
            int idx = (cur == mx) ? e : 99;
#pragma unroll
            for (int o = 1; o < 32; o <<= 1) idx = min(idx, __shfl_xor(idx, o));
            tv[k] = mx; ti[k] = idx;
            if (e == idx) cur = -INFINITY;
        }
        const float e1 = __expf(tv[1] - tv[0]), e2 = __expf(tv[2] - tv[0]), e3 = __expf(tv[3] - tv[0]);
        const float inv = 1.f / (1.f + e1 + e2 + e3);
        s_ex[it] = e == 0 ? ti[0] : e == 1 ? ti[1] : e == 2 ? ti[2] : ti[3];
        s_gt[it] = (e == 0 ? 1.f : e == 1 ? e1 : e == 2 ? e2 : e3) * inv;
        s_lp[it] = 0;
        if (e < 4) s_lp[it] = __hip_atomic_fetch_add(&lcnt[s_ex[it]], 1, __ATOMIC_RELAXED, __HIP_MEMORY_SCOPE_WORKGROUP);
        if (e == 4) RSTD[blk * 64 + rl] = rstd;
    }
    __syncthreads();
    if (tid < 32) { const int n = lcnt[tid]; lbase[tid] = n ? atomicAdd(&cnt[tid * CNT_STRIDE], n) : 0; }
    __syncthreads();
    if (r < 4) {
#pragma unroll
        for (int it = 0; it < 4; ++it) { const int grow = blk * 64 + wave * 8 + it * 2 + hh, pos = lbase[s_ex[it]] + s_lp[it];
            tok_list[s_ex[it] * T + pos] = grow;
            sel_e[grow * 4 + r] = s_ex[it]; sel_gate[grow * 4 + r] = s_gt[it]; sel_pos[grow * 4 + r] = pos; }
    }
    __syncthreads();
}
constexpr int NWAVES = 8;
constexpr int RING_BYTES = 131072;
constexpr int LDSCTL_OFF = RING_BYTES, MISC_OFF = LDSCTL_OFF + 320;
constexpr int TAB_OFF = RING_BYTES + 1024;
constexpr int ROWS_OFF = TAB_OFF + 512;
constexpr int LDS_BYTES = 163840, ROWTABS = 14;
constexpr int RSTD_OFF = ROWS_OFF + ROWTABS * 1024;
static_assert(RSTD_OFF + ROWTABS * 1024 <= LDS_BYTES, "LDS map");

#ifndef MOE_W_ITEMS
#define MOE_W_ITEMS 20480
#endif
enum Phase { PH_PROLOGUE = 0, PH_INPROJ, PH_GLA_A, PH_SCAN, PH_GLA_C, PH_OUTPROJ, PH_ROUTER, PH_MOE1, PH_MOE2, PH_COMBINE, PH_N };

struct Args { const float* in[19]; float* out; unsigned char* ws; int ph_lo, ph_hi, li, pad; };

struct GridOrder {
    int nN, nunits, G, v;
    __device__ __forceinline__ bool next(int i, pg8::Unit& u) const {
        const int L = i * G + v; if (L >= nunits) return false;
        const int gs = 8 * nN, grp = L / gs, rem = L % gs;
        u.pm = grp * 8 + (rem & 7); u.pn = rem >> 3; u.am = u.pm; u.bn = u.pn; u.e = 0; u.ui = i; u.skip = 0; u.kind = 0; return true;
    }
    __device__ __forceinline__ const LAS int* rows(int) const { return nullptr; }
    __device__ __forceinline__ const char* abase(const pg8::Unit&) const { return nullptr; }
    __device__ __forceinline__ const char* bbase(const pg8::Unit&, size_t) const { return nullptr; }
    __device__ __forceinline__ void a_ready(const pg8::Unit&) const {}
    __device__ __forceinline__ void done(const pg8::Unit&) const {}
};
struct MoeOrder {
    const LAS int* tstart; const LAS int* rowtab; int ncol, ntile, G, v;
    __device__ __forceinline__ static int expert_of(const LAS int* ts, int R) { int e = 0;
#pragma unroll
        for (int j = 1; j < NE; ++j) e += (ts[j] <= R) ? 1 : 0;
        return e; }
    __device__ __forceinline__ bool map(int i, int& R, int& pn) const {
        const int li = i * G + v; if (li >= ntile * ncol) return false;
        R = li / ncol; pn = li % ncol; return true;
    }
    __device__ __forceinline__ bool next(int i, pg8::Unit& u) const {
        int R, pn; if (!map(i, R, pn)) return false;
        u.pm = R; u.pn = pn; u.am = R; u.e = expert_of(tstart, R); u.bn = u.e * ncol + pn; u.ui = i; u.skip = 0; u.kind = 0;
        return true;
    }
    __device__ __forceinline__ const LAS int* rows(int ui) const { return rowtab + ui * 256; }
    __device__ __forceinline__ const char* abase(const pg8::Unit&) const { return nullptr; }
    __device__ __forceinline__ const char* bbase(const pg8::Unit&, size_t) const { return nullptr; }
    __device__ __forceinline__ void a_ready(const pg8::Unit&) const {}
    __device__ __forceinline__ void done(const pg8::Unit&) const {}
};

struct P0Item { const float* W; unsigned char* WT; int ldw, ncols, k0, n0, dst_row0; };
__device__ __forceinline__ void p0_load(const P0Item& t, float4 (&v)[8], int lane) {
    const int c = t.n0 + 4 * (lane & 7);
#pragma unroll
    for (int i = 0; i < 8; ++i) { const int kk = (lane >> 3) + 8 * i; v[i] = (c < t.ncols) ? *(const float4*)(t.W + (size_t)(t.k0 + kk) * t.ldw + c) : make_float4(0.f, 0.f, 0.f, 0.f); }
}
template <bool F8> __device__ __forceinline__ void p0_finish(const P0Item& t, const float4 (&v)[8], LAS float* scr, int lane) {
#pragma unroll
    for (int i = 0; i < 8; ++i) { LAS float* d = scr + ((lane >> 3) + 8 * i) * 33 + 4 * (lane & 7); d[0] = v[i].x; d[1] = v[i].y; d[2] = v[i].z; d[3] = v[i].w; }
    LDS_WAIT(); asm volatile("" ::: "memory");
    const int c8 = lane & 7;
#pragma unroll
    for (int j = 0; j < 4; ++j) { const int n = (lane >> 3) + 8 * j; const LAS float* s = scr + (8 * c8) * 33 + n;
        if constexpr (F8) { typedef unsigned u32x2 __attribute__((ext_vector_type(2))); u32x2 o8;
            o8.x = pg8::pack4_fp8(s[0 * 33] * FP8_SW, s[1 * 33] * FP8_SW, s[2 * 33] * FP8_SW, s[3 * 33] * FP8_SW); o8.y = pg8::pack4_fp8(s[4 * 33] * FP8_SW, s[5 * 33] * FP8_SW, s[6 * 33] * FP8_SW, s[7 * 33] * FP8_SW);
            *(u32x2*)(t.WT + (size_t)(t.dst_row0 + n) * 1024 + t.k0 + 8 * c8) = o8; }
        else { v4u o; o.x = pk2(s[0 * 33], s[1 * 33]); o.y = pk2(s[2 * 33], s[3 * 33]); o.z = pk2(s[4 * 33], s[5 * 33]); o.w = pk2(s[6 * 33], s[7 * 33]);
            *(v4u*)((bf16*)t.WT + (size_t)(t.dst_row0 + n) * 1024 + t.k0 + 8 * c8) = o; } }
    LDS_WAIT(); asm volatile("" ::: "memory");
}
constexpr int P0_IN_ITEMS = 16 * 80, P0_OUT_ITEMS = 16 * 32, P0_SMALL_ITEMS = P0_IN_ITEMS + P0_OUT_ITEMS, P0_EXP_ITEMS = 3 * 512, P0_MOE_ITEMS = NE * P0_EXP_ITEMS;
__device__ __forceinline__ P0Item p0_small_item(const Args& a, int it) {
    if (it < P0_IN_ITEMS) { const int kb = it / 80, nb = it % 80; return P0Item{a.in[2], a.ws + WS_WIN, DIN, DIN, 64 * kb, 32 * nb, 32 * nb}; }
    it -= P0_IN_ITEMS; const int kb = it / 32, nb = it % 32; return P0Item{a.in[8], a.ws + WS_WOUT, D, D, 64 * kb, 32 * nb, 32 * nb};
}
__device__ __forceinline__ P0Item p0_moe_item(const Args& a, int it) {
    constexpr int EB = MOE_FP8 ? 1 : 2;
    const int e = it / P0_EXP_ITEMS, r = it % P0_EXP_ITEMS, mat = r / 512, r2 = r % 512, kb = r2 / 32, n0 = 32 * (r2 % 32);
    if (mat == 2) return P0Item{a.in[16] + (size_t)e * D * D, a.ws + WS_WD + (size_t)e * D * D * EB, D, D, 64 * kb, n0, n0};
    return P0Item{(mat == 0 ? a.in[12] : a.in[14]) + (size_t)e * D * D, a.ws + WS_WGL + (size_t)e * 2 * D * D * EB, D, D, 64 * kb, n0, (n0 >> 7) * 256 + (n0 & 127) + (mat == 1 ? 128 : 0)};
}
__device__ __forceinline__ void p0_moe_stream(const Args& a, int first, int last, int w, int nw, LAS float* scr, int lane) {
    float4 va[8], vb[8], vc[8];
    int it = first + w;
    if (it < last) p0_load(p0_moe_item(a, it), va, lane);
    if (it + nw < last) p0_load(p0_moe_item(a, it + nw), vb, lane);
    for (; it < last; it += 3 * nw) {
        if (it + 2 * nw < last) p0_load(p0_moe_item(a, it + 2 * nw), vc, lane);
        p0_finish<MOE_FP8 != 0>(p0_moe_item(a, it), va, scr, lane);
        if (it + 3 * nw < last) p0_load(p0_moe_item(a, it + 3 * nw), va, lane);
        if (it + nw < last) p0_finish<MOE_FP8 != 0>(p0_moe_item(a, it + nw), vb, scr, lane);
        if (it + 4 * nw < last) p0_load(p0_moe_item(a, it + 4 * nw), vb, lane);
        if (it + 2 * nw < last) p0_finish<MOE_FP8 != 0>(p0_moe_item(a, it + 2 * nw), vc, scr, lane);
    }
}

__global__ void __launch_bounds__(NWAVES * 64, 2) mk_fwd(Args args) {
    extern __shared__ __attribute__((aligned(16))) unsigned char lds_raw[];
    LAS unsigned char* lds = (LAS unsigned char*)lds_raw;
    volatile LAS unsigned* MISC = (volatile LAS unsigned*)(lds + MISC_OFF);
    const int tid = threadIdx.x, lane = tid & 63, wave = __builtin_amdgcn_readfirstlane(tid >> 6);
    const int G = gridDim.x; int vcu; { const int bx = blockIdx.x; vcu = (G % 8 == 0) ? (bx % 8) * (G / 8) + bx / 8 : bx; }
    unsigned char* ws = args.ws;
    unsigned* ctl = (unsigned*)(ws + WS_CTL);
    for (int u = tid; u < (LDS_BYTES - LDSCTL_OFF) / 4; u += NWAVES * 64) ((LAS unsigned*)(lds + LDSCTL_OFF))[u] = 0u;
    __syncthreads();
    const int lo = args.ph_lo, hi = args.ph_hi;
#define IN(k) (lo <= (k) && (k) < hi)
#ifndef NWK_PER_XCD
#define NWK_PER_XCD 27
#endif
    constexpr int NWK = NWK_PER_XCD;
        const bool split = (lo == 0 && hi == PH_N && G == 256);
    const bool conv = split && (vcu & 31) >= NWK;
    const int wi = split ? (vcu >> 5) * NWK + (vcu & 31) : vcu, WG = split ? 8 * NWK : G;
    XcdBarrier barW = xcd_barrier_post(ctl + CW_BAR + (2 * args.li) * XCD_BAR_WORDS, MISC + 8, (unsigned)WG, split && !conv);
    XcdBarrier barA = xcd_barrier_post(ctl + CW_BAR + (2 * args.li + 1) * XCD_BAR_WORDS, MISC + 12, (unsigned)G, true);
#define SEAM(k) do { if (IN(k) && IN((k) + 1)) { if (split && (k) < PH_GLA_C) xcd_barrier(barW); else xcd_barrier(barA); } } while (0)
    const int gw = vcu * NWAVES + wave, NGW = G * NWAVES;
    const int gww = wi * NWAVES + wave, NGWW = WG * NWAVES;
    LAS float* scr = (LAS float*)(lds + wave * 16384);
    constexpr int MOE_ITEMS_BY_WORKERS = MOE_W_ITEMS;

    if (conv) {
        const int cw = ((vcu >> 5) * (32 - NWK) + ((vcu & 31) - NWK)) * NWAVES + wave, ncw = 8 * (32 - NWK) * NWAVES;
        p0_moe_stream(args, MOE_ITEMS_BY_WORKERS, P0_MOE_ITEMS, cw, ncw, scr, lane);
    } else {
    if (IN(PH_PROLOGUE)) {
        for (int it = gww; it < P0_SMALL_ITEMS; it += NGWW) { float4 v[8]; const P0Item t = p0_small_item(args, it); p0_load(t, v, lane); p0_finish<false>(t, v, scr, lane); }
        p0_moe_stream(args, 0, split ? MOE_ITEMS_BY_WORKERS : P0_MOE_ITEMS, gww, NGWW, scr, lane);
        xn_rows(args.in[0], args.in[1], (bf16*)(ws + WS_XN), gww, NGWW, lane);
        for (int idx = (wi * NWAVES * 64) + tid; idx < NE * D; idx += WG * NWAVES * 64) { const int e = idx >> 10, k = idx & 1023; const float x = args.in[10][k * NE + e];
            const unsigned hi_ = f2bf(x); ((bf16*)(ws + WS_WRH))[idx] = (bf16)hi_; ((bf16*)(ws + WS_WRL))[idx] = (bf16)f2bf(x - __builtin_bit_cast(float, hi_ << 16)); }
    }
    SEAM(PH_PROLOGUE);
    if (IN(PH_INPROJ)) {
        pg8::Gemm g{(const bf16*)(ws + WS_XN), (const bf16*)(ws + WS_WIN), D};
        GridOrder S{DINP / 256, (T / 256) * (DINP / 256), WG, wi};
        pg8::EpiOut<0> E{(bf16*)(ws + WS_PROJ), DINP, nullptr, 0, 1.f, 1.f};
        pg8::gemm_phase<pg8::EpiOut<0>, GridOrder, true, false>(lds, g, S, E);
    }
    SEAM(PH_INPROJ);
    if (IN(PH_GLA_A)) {
        const bf16* PROJp = (const bf16*)(ws + WS_PROJ);
        {
            int U = wi; SwaRaw cur; if (U < 512) cur = swa_load(U, PROJp, tid, lane, wave);
            for (; U < 512; U += WG) { SwaRaw nxt; const bool hn = U + WG < 512; if (hn) nxt = swa_load(U + WG, PROJp, tid, lane, wave);
                swa_unit(U, cur, args.in[6], args.in[7], (bf16*)(ws + WS_CAT), lds, tid, lane, wave); if (hn) cur = nxt; }
            GlaARaw ca; if (U < 1536) ca = gla_a_load(U - 512, PROJp, args.in[3], args.in[4], lane, wave);
            for (; U < 1536; U += WG) { GlaARaw na; const bool hn = U + WG < 1536; if (hn) na = gla_a_load(U + WG - 512, PROJp, args.in[3], args.in[4], lane, wave);
                gla_a_unit(U - 512, ca, PROJp, args.in[3], args.in[4], (float*)(ws + WS_KV), (float*)(ws + WS_DECAY), (float*)(ws + WS_BLG), lds, tid, lane, wave); if (hn) ca = na; }
        }
    }
    SEAM(PH_GLA_A);
    if (IN(PH_SCAN)) {
        for (int id = (tid >> 8) * (WG * 256) + wi * 256 + (tid & 255); id < 65536; id += WG * 512) gla_scan(id, (const float*)(ws + WS_KV), (const float*)(ws + WS_DECAY), (bf16*)(ws + WS_SPREV));
    }
    SEAM(PH_SCAN);
    if (IN(PH_GLA_C)) {
        int U = wi; GlaCRaw cur; if (U < 1024) cur = gla_c_load(U, (const bf16*)(ws + WS_PROJ), (const float*)(ws + WS_BLG), (const bf16*)(ws + WS_SPREV), tid, lane, wave);
        for (; U < 1024; U += WG) { GlaCRaw nxt; const bool hn = U + WG < 1024; if (hn) nxt = gla_c_load(U + WG, (const bf16*)(ws + WS_PROJ), (const float*)(ws + WS_BLG), (const bf16*)(ws + WS_SPREV), tid, lane, wave);
            gla_c_unit(U, cur, args.in[5], (bf16*)(ws + WS_CAT), lds, tid, lane, wave); if (hn) cur = nxt; }
    }
    }
    SEAM(PH_GLA_C);
    if (IN(PH_OUTPROJ)) {
        pg8::Gemm g{(const bf16*)(ws + WS_CAT), (const bf16*)(ws + WS_WOUT), D};
        GridOrder S{D / 256, (T / 256) * (D / 256), G, vcu};
        pg8::EpiOut<0> E{(bf16*)(ws + WS_ATT), D, nullptr, 0, 1.f, 1.f};
        pg8::gemm_phase<pg8::EpiOut<0>, GridOrder, false, false>(lds, g, S, E);
    }
    SEAM(PH_OUTPROJ);
    int* cntg = (int*)ctl + CW_CNT; int* tokl = (int*)(ws + WS_TOKL);
    int* sel_e = (int*)(ws + WS_SEL); float* sel_gate = (float*)(ws + WS_SEL + 256 * 1024); int* sel_pos = (int*)(ws + WS_SEL + 512 * 1024);
    if (IN(PH_ROUTER)) {
        for (int blk = vcu; blk < T / 64; blk += G)
            router_block(blk, args.in[0], (bf16*)(ws + WS_ATT), args.in[9], (const bf16*)(ws + WS_WRH), (const bf16*)(ws + WS_WRL), args.in[11], (bf16*)(ws + WS_HN), (float*)(ws + WS_RSTD),
                         cntg, tokl, sel_e, sel_gate, sel_pos,
                         lds, tid, lane, wave);
    }
    SEAM(PH_ROUTER);
    LAS int* tab = (LAS int*)(lds + TAB_OFF);
    if (IN(PH_MOE1)) {
        if (wave == 0) { int mycnt; const int ts = lane_tstart(cntg, lane, mycnt); if (lane < NE) { tab[lane] = ts; tab[33 + lane] = mycnt; } if (lane == NE - 1) tab[32] = ts + ((mycnt + 255) >> 8); }
        __syncthreads();
        LAS int* rowtab = (LAS int*)(lds + ROWS_OFF);
        MoeOrder S{tab, rowtab, 8, tab[32], G, vcu};
        LAS int* uinfo = (LAS int*)(lds + TAB_OFF + 288);
        if (tid < ROWTABS) { int R, pn; int base = -1, nval = 0;
            if (S.map(tid, R, pn)) { const int e = MoeOrder::expert_of(tab, R), rt = R - tab[e]; base = e * T + rt * 256; nval = tab[33 + e] - rt * 256; }
            uinfo[tid * 3] = base; uinfo[tid * 3 + 1] = nval; }
        __syncthreads();
        { int tk[(ROWTABS * 256 + 511) / 512];
#pragma unroll
          for (int k = 0; k < (ROWTABS * 256 + 511) / 512; ++k) { const int idx = tid + 512 * k, j = idx >> 8, r = idx & 255; const int base = uinfo[j * 3], nval = uinfo[j * 3 + 1];
              tk[k] = (base >= 0) ? tokl[base + (r < nval ? r : 0)] : -1; }
#pragma unroll
          for (int k = 0; k < (ROWTABS * 256 + 511) / 512; ++k) { const int idx = tid + 512 * k;
              if (tk[k] >= 0) { rowtab[idx] = tk[k]; ((LAS float*)(lds + RSTD_OFF))[idx] = ((const float*)(ws + WS_RSTD))[tk[k]]; } } }
        __syncthreads();
        pg8::Gemm g{(const bf16*)(ws + WS_HN), (const bf16*)(ws + WS_WGL), MOE_FP8 ? D / 2 : D};
        pg8::EpiSwiglu E{(bf16*)(ws + WS_HID), args.in[13], args.in[15], (const LAS float*)(lds + RSTD_OFF), MOE_FP8 ? 1.f / (FP8_SA * FP8_SW) : 1.f, MOE_FP8, FP8_SH, 0};
        pg8::gemm_phase<pg8::EpiSwiglu, MoeOrder, true, true, MOE_FP8 != 0>(lds, g, S, E);
    }
    SEAM(PH_MOE1);
    if (IN(PH_MOE2)) {
        if (wave == 0) { int mycnt; const int ts = lane_tstart(cntg, lane, mycnt); if (lane < NE) { tab[lane] = ts; tab[33 + lane] = mycnt; } if (lane == NE - 1) tab[32] = ts + ((mycnt + 255) >> 8); }
        __syncthreads();
        LAS int* rowtab = (LAS int*)(lds + ROWS_OFF);
        MoeOrder S{tab, rowtab, 4, tab[32], G, vcu};
        for (int j = 0; j < ROWTABS; ++j) { int R, pn; if (!S.map(j, R, pn)) break; if (tid < 256) rowtab[j * 256 + tid] = R * 256 + tid; }
        __syncthreads();
        pg8::Gemm g{(const bf16*)(ws + WS_HID), (const bf16*)(ws + WS_WD), MOE_FP8 ? D / 2 : D};
        pg8::EpiOut<1> E{(bf16*)(ws + WS_Y), D, args.in[17], D, 1.f / (FP8_SH * FP8_SW), FP8_SY};
        pg8::gemm_phase<pg8::EpiOut<1>, MoeOrder, true, true, true>(lds, g, S, E);
    }
    SEAM(PH_MOE2);
    if (IN(PH_COMBINE)) {
        combine_rows((const bf16*)(ws + WS_ATT), args.out, (const unsigned char*)(ws + WS_Y), cntg, sel_e, sel_gate, sel_pos, args.in[18], gw, NGW, lane);
    }
#undef IN
#undef SEAM
}
extern "C" void kernel_launch(void* const* d_in, const int* in_sizes, int n_in, void* d_out, int out_size, void* d_ws, size_t ws_size, hipStream_t stream) {
    static int grid = 0;
    if (grid == 0) {
        if (n_in != 19 || out_size != T * D || ws_size < WS_END) { fprintf(stderr, "kernel_launch: unexpected shapes (n_in %d out %d ws %zu)\n", n_in, out_size, ws_size); grid = -1; return; }
        int dev = 0, cus = 0, per_cu = 0;
        if (hipGetDevice(&dev) != hipSuccess || hipDeviceGetAttribute(&cus, hipDeviceAttributeMultiprocessorCount, dev) != hipSuccess) { grid = -1; return; }
        if (hipFuncSetAttribute((const void*)mk_fwd, hipFuncAttributeMaxDynamicSharedMemorySize, LDS_BYTES) != hipSuccess) { fprintf(stderr, "kernel_launch: hipFuncSetAttribute failed\n"); grid = -1; return; }
        if (hipOccupancyMaxActiveBlocksPerMultiprocessor(&per_cu, (const void*)mk_fwd, NWAVES * 64, LDS_BYTES) != hipSuccess || per_cu < 1) fprintf(stderr, "kernel_launch: occupancy query says %d\n", per_cu);
        (void)hipGetLastError();
        grid = cus;
    }
    if (grid < 0) return;
    (void)hipMemsetAsync((unsigned char*)d_ws + WS_CTL, 0, CTL_ZERO_BYTES, stream);
    Args a{};
    for (int i = 0; i < 19; ++i) a.in[i] = (const float*)d_in[i];
    a.out = (float*)d_out; a.ws = (unsigned char*)d_ws; a.ph_lo = 0; a.ph_hi = PH_N; a.li = 0;
    hipLaunchKernelGGL(mk_fwd, dim3(grid), dim3(NWAVES * 64), LDS_BYTES, stream, a);
}
```

```cpp
#include <hip/hip_runtime.h>
#include <cstdio>
#include <cstdint>

constexpr int BATCH = 2, SEQ = 8192, T = BATCH * SEQ, D = 1024, DIN = 2320, DINP = 2560;
constexpr int NE = 32, TOPK = 4;
constexpr int C_QA = 0, C_KA = 256, C_VA = 512, C_RA = 1024, C_ZA = 1536, C_QB = 1552, C_KB = 2064, C_VB = 2192;
constexpr float EPS = 1e-5f;
constexpr int PMAX = 73728;
constexpr size_t MiB = 1u << 20;
constexpr size_t WS_CTL = 0, CTL_ZERO_BYTES = 1 * MiB;
constexpr size_t WS_TOKL = 1 * MiB;
constexpr size_t WS_SEL = 3 * MiB;
constexpr size_t WS_RSTD = 3 * MiB + 768 * 1024;
constexpr size_t WS_WRH = 11 * MiB, WS_WRL = 11 * MiB + 65536;
constexpr size_t WS_WIN = 4 * MiB;
constexpr size_t WS_WOUT = 9 * MiB;
constexpr size_t WS_WD = 16 * MiB;
constexpr size_t WS_WGL = 80 * MiB;
constexpr size_t WS_HN = 208 * MiB;
constexpr size_t WS_PROJ = 240 * MiB;
constexpr size_t WS_XN = 320 * MiB;
constexpr size_t WS_CAT = 352 * MiB;
constexpr size_t WS_ATT = 320 * MiB;
constexpr size_t WS_HID = 240 * MiB;
constexpr size_t WS_Y = 80 * MiB;
constexpr size_t WS_KV = 384 * MiB;
constexpr size_t WS_SPREV = 416 * MiB;
constexpr size_t WS_DECAY = 432 * MiB;
constexpr size_t WS_BLG = 440 * MiB;
constexpr size_t WS_END = 456 * MiB;
constexpr int CW_CNT = 0, CNT_STRIDE = 32;
constexpr int CW_BAR = 4096;

#ifndef MOE_FP8
#define MOE_FP8 1
#endif
#ifndef Y_FP8
#define Y_FP8 1
#endif
constexpr float FP8_SW = 64.f, FP8_SA = 8.f, FP8_SH = 4.f, FP8_SY = 16.f;
static_assert(MOE_FP8, "the workspace map assumes fp8 HID (72 MiB)");
typedef unsigned short bf16;
__device__ __forceinline__ float bf2f(bf16 v) { return __builtin_bit_cast(float, (unsigned)v << 16); }
typedef float f32x2_t __attribute__((ext_vector_type(2))); typedef __bf16 bf16x2_t __attribute__((ext_vector_type(2)));
__device__ __forceinline__ unsigned pk2(float lo, float hi) { const f32x2_t v = {lo, hi}; const bf16x2_t b = __builtin_convertvector(v, bf16x2_t); return __builtin_bit_cast(unsigned, b); }
__device__ __forceinline__ unsigned f2bf(float f) { return pk2(f, 0.f) & 0xffffu; }
__device__ __forceinline__ float ldf(const float* p) { return *p; }
__device__ __forceinline__ float ldf(const bf16* p) { return bf2f(*p); }

__device__ __forceinline__ float wave_sum(float v) {
#pragma unroll
    for (int o = 1; o < 64; o <<= 1) v += __shfl_xor(v, o);
    return v;
}
__device__ __forceinline__ float wave_max(float v) {
#pragma unroll
    for (int o = 1; o < 64; o <<= 1) v = fmaxf(v, __shfl_xor(v, o));
    return v;
}
__device__ __forceinline__ float logsigmoidf(float x) { return fminf(x, 0.f) - log1pf(expf(-fabsf(x))); }
__device__ __forceinline__ float logsigmoid_fast(float x) { return fminf(x, 0.f) - __logf(1.f + __expf(-fabsf(x))); }
namespace pg8 {
#define PG8_LAS __attribute__((address_space(3)))
typedef unsigned short bf16_t;
typedef short bf16x8 __attribute__((ext_vector_type(8)));
typedef float f32x4 __attribute__((ext_vector_type(4)));
typedef unsigned u32x4 __attribute__((ext_vector_type(4)));
constexpr int BM = 256, BK = 64, HALF = 128, HTB = HALF * BK * 2  , STAGE_BYTES = 8 * HTB;

__host__ __device__ __forceinline__ int lds_byte(int r, int c) { const int st = (r >> 4) * 2 + (c >> 5), rr = r & 15, cc = c & 31, ob = rr * 64 + cc * 2; return st * 1024 + (ob ^ (((ob >> 9) & 1) << 5)); }
__host__ __device__ __forceinline__ void stage_rc(int b, int& R, int& C) { const int st = b / 1024, sb = b % 1024, swz = sb ^ (((sb >> 9) & 1) << 5); R = (st >> 1) * 16 + swz / 64; C = (st & 1) * 32 + (swz % 64) / 2; }
__host__ __device__ __forceinline__ int perm32(int rho) { const int n = rho >> 4, i = rho & 15; return 8 * (i >> 2) + 4 * n + (i & 3); }

struct Unit { int pm, pn, am, bn, e, ui, skip, kind; };
struct Gemm { const bf16_t* A; const bf16_t* Bt; int K; };

typedef int v8i32 __attribute__((ext_vector_type(8)));
__device__ __forceinline__ v8i32 cat8(bf16x8 lo, bf16x8 hi) { const u32x4 a = __builtin_bit_cast(u32x4, lo), b = __builtin_bit_cast(u32x4, hi); return (v8i32){(int)a.x, (int)a.y, (int)a.z, (int)a.w, (int)b.x, (int)b.y, (int)b.z, (int)b.w}; }
__device__ __forceinline__ unsigned cvt_pk_bf16(float lo, float hi) { unsigned r; asm volatile("v_cvt_pk_bf16_f32 %0, %1, %2" : "=v"(r) : "v"(lo), "v"(hi)); return r; }

template <class Epi, class Sched, bool ALIGN_EPI, bool GATHER, bool FP8 = false, bool HOOKS = false>
__device__ __forceinline__ void gemm_phase(PG8_LAS unsigned char* lds, const Gemm g, const Sched& S, const Epi& E) {
    const int tid = threadIdx.x, wid = __builtin_amdgcn_readfirstlane(tid >> 6), lane = tid & 63, wr = wid >> 2, wc = wid & 3, fr = lane & 15, fq = lane >> 4;
    int K = g.K; asm volatile("" : "+s"(K));
    const int nt = K / BK;
    const size_t kstep = (size_t)(BK * 2);
    const size_t hstep = (size_t)HALF * K * 2;
    const size_t tstep = 2 * hstep;
    unsigned voffA0[2], voffA1[2], voffB[2];
#pragma unroll
    for (int i = 0; i < 2; ++i) { int R, C; stage_rc(tid * 16 + i * 8192, R, C); const int Rb = Epi::PERM ? ((R & ~31) + perm32(R & 31)) : R;
        voffA0[i] = (unsigned)(R * K + C) * 2u; voffA1[i] = voffA0[i] + (unsigned)hstep; voffB[i] = (unsigned)(Rb * K + C) * 2u; }
    const unsigned ldsw = (unsigned)wid * 1024u;
    const int aoff = lds_byte(wr * 64 + fr, fq * 8), boff = lds_byte(wc * 32 + fr, fq * 8);
#define PG8_SA(b, h) (((b) * 2 + (h)) * HTB)
#define PG8_SB(b, h) ((4 + (b) * 2 + (h)) * HTB)
#define PG8_STAGE(bufoff, gbase, voff) do { _Pragma("unroll") for (int _i = 0; _i < 2; ++_i) \
        __builtin_amdgcn_global_load_lds((const unsigned*)((const char*)(gbase) + (voff)[_i]), (PG8_LAS unsigned*)(lds + (bufoff) + ldsw + _i * 8192), 16, 0, 0); } while (0)
#define PG8_LDA(dst, b, h) do { _Pragma("unroll") for (int m = 0; m < 4; ++m) { if constexpr (FP8) { dst##8[m] = cat8(*(const PG8_LAS bf16x8*)(lds + PG8_SA(b, h) + aoff + m * 2048), *(const PG8_LAS bf16x8*)(lds + PG8_SA(b, h) + aoff + m * 2048 + 1024)); } \
        else { _Pragma("unroll") for (int k = 0; k < 2; ++k) dst[m][k] = *(const PG8_LAS bf16x8*)(lds + PG8_SA(b, h) + aoff + m * 2048 + k * 1024); } } } while (0)
#define PG8_LDB(dst, b, h) do { _Pragma("unroll") for (int n = 0; n < 2; ++n) { if constexpr (FP8) { dst##8[n] = cat8(*(const PG8_LAS bf16x8*)(lds + PG8_SB(b, h) + boff + n * 2048), *(const PG8_LAS bf16x8*)(lds + PG8_SB(b, h) + boff + n * 2048 + 1024)); } \
        else { _Pragma("unroll") for (int k = 0; k < 2; ++k) dst[n][k] = *(const PG8_LAS bf16x8*)(lds + PG8_SB(b, h) + boff + n * 2048 + k * 1024); } } } while (0)
#define PG8_MMA(ai, bj, At, Bt) do { __builtin_amdgcn_s_setprio(1); _Pragma("unroll") for (int m = 0; m < 4; ++m) _Pragma("unroll") for (int n = 0; n < 2; ++n) { \
        if constexpr (FP8) { acc[ai][bj][m][n] = __builtin_amdgcn_mfma_scale_f32_16x16x128_f8f6f4(Bt##8[n], At##8[m], acc[ai][bj][m][n], 0, 0, 0, 0x7f7f7f7f, 0, 0x7f7f7f7f); } \
        else { _Pragma("unroll") for (int k = 0; k < 2; ++k) acc[ai][bj][m][n] = __builtin_amdgcn_mfma_f32_16x16x32_bf16(Bt[n][k], At[m][k], acc[ai][bj][m][n], 0, 0, 0); } } \
        __builtin_amdgcn_s_setprio(0); } while (0)
#define PG8_WAIT_V(n) asm volatile("s_waitcnt vmcnt(" #n ")" ::: "memory")
#define PG8_WAIT_L(n) asm volatile("s_waitcnt lgkmcnt(" #n ")" ::: "memory")
#define PG8_BAR __builtin_amdgcn_s_barrier()
#define PG8_SCHED __builtin_amdgcn_sched_barrier(0)
#define PG8_GROWS(tab) do { _Pragma("unroll") for (int _i = 0; _i < 2; ++_i) { int R_, C_; stage_rc(tid * 16 + _i * 8192, R_, C_); \
        voffA0[_i] = (unsigned)((tab)[R_] * K + C_) * 2u; voffA1[_i] = (unsigned)((tab)[HALF + R_] * K + C_) * 2u; } } while (0)
    Unit cur, nxt; int ui = 0;
    if (!S.next(0, cur)) return;
    if constexpr (HOOKS) S.a_ready(cur);
    if constexpr (GATHER) { PG8_GROWS(S.rows(0)); }
    f32x4 acc[2][2][4][2];
#pragma unroll
    for (int a = 0; a < 2; ++a)
#pragma unroll
        for (int b = 0; b < 2; ++b)
#pragma unroll
            for (int m = 0; m < 4; ++m)
#pragma unroll
                for (int n = 0; n < 2; ++n) acc[a][b][m][n] = (f32x4){0.f, 0.f, 0.f, 0.f};
    bf16x8 At[4][2], B0[2][2], B1[2][2];
    v8i32 At8[4], B08[2], B18[2];
    const char* cA = HOOKS ? S.abase(cur) : (GATHER ? (const char*)g.A : (const char*)g.A + (size_t)cur.am * tstep); const char* cB = HOOKS ? S.bbase(cur, tstep) : (const char*)g.Bt + (size_t)cur.bn * tstep;
    PG8_STAGE(PG8_SB(0, 0), cB, voffB); PG8_STAGE(PG8_SB(0, 1), cB + hstep, voffB); PG8_STAGE(PG8_SA(0, 0), cA, voffA0); PG8_STAGE(PG8_SA(0, 1), cA, voffA1);
    if (wr == 1) PG8_BAR;
    PG8_WAIT_V(2); PG8_BAR;
    PG8_STAGE(PG8_SB(1, 0), cB + kstep, voffB); PG8_STAGE(PG8_SA(1, 0), cA + kstep, voffA0); PG8_STAGE(PG8_SB(1, 1), cB + hstep + kstep, voffB);
    PG8_WAIT_V(6); PG8_BAR;
    for (;;) {
        const bool has_next = S.next(ui + 1, nxt);
        const char* nA = HOOKS ? (has_next ? S.abase(nxt) : cA) : (GATHER ? (const char*)g.A : (has_next ? (const char*)g.A + (size_t)nxt.am * tstep : cA));
        const char* nB = has_next ? (HOOKS ? S.bbase(nxt, tstep) : (const char*)g.Bt + (size_t)nxt.bn * tstep) : cB;
#pragma unroll 1
        for (int t = 0; t < nt; t += 2) {
            const bool last = (t == nt - 2);
            const char* a1 = cA + (size_t)(t + 1) * kstep;
            const char* a2 = last ? nA : cA + (size_t)(t + 2) * kstep; const char* b2 = last ? nB : cB + (size_t)(t + 2) * kstep;
            const char* a3 = a2 + kstep; const char* b3 = b2 + kstep;
            if constexpr (HOOKS) { if (last && has_next) S.a_ready(nxt); }
            PG8_LDB(B0, 0, 0); PG8_LDB(B1, 0, 1); PG8_SCHED; PG8_LDA(At, 0, 0); PG8_STAGE(PG8_SA(1, 1), a1, voffA1);
            if constexpr (GATHER) { if (last && has_next) { PG8_GROWS(S.rows(ui + 1)); } }
            PG8_WAIT_V(8); PG8_WAIT_L(0); PG8_BAR; PG8_MMA(0, 0, At, B0); PG8_MMA(0, 1, At, B1); PG8_BAR; PG8_SCHED;
            PG8_LDA(At, 0, 1); PG8_STAGE(PG8_SB(0, 0), b2, voffB); PG8_STAGE(PG8_SB(0, 1), b2 + hstep, voffB); PG8_STAGE(PG8_SA(0, 0), a2, voffA0);
            PG8_WAIT_V(8); PG8_WAIT_L(0); PG8_BAR; PG8_MMA(1, 0, At, B0); PG8_MMA(1, 1, At, B1); PG8_BAR; PG8_SCHED;
            PG8_LDB(B0, 1, 0); PG8_LDB(B1, 1, 1); PG8_SCHED; PG8_LDA(At, 1, 0); PG8_STAGE(PG8_SA(0, 1), a2, voffA1);
            PG8_WAIT_V(8); PG8_WAIT_L(0); PG8_BAR; PG8_MMA(0, 0, At, B0); PG8_MMA(0, 1, At, B1); PG8_BAR; PG8_SCHED;
            PG8_LDA(At, 1, 1); PG8_STAGE(PG8_SB(1, 0), b3, voffB); PG8_STAGE(PG8_SB(1, 1), b3 + hstep, voffB); PG8_STAGE(PG8_SA(1, 0), a3, voffA0);
            PG8_WAIT_V(8); PG8_WAIT_L(0); PG8_BAR; PG8_MMA(1, 0, At, B0); PG8_MMA(1, 1, At, B1); PG8_BAR; PG8_SCHED;
        }
        if constexpr (ALIGN_EPI) { if (wr == 0) PG8_BAR; }
        E(acc, cur, wr, wc, fr, fq);
        if constexpr (HOOKS) S.done(cur);
        if (!has_next) break;
#pragma unroll
        for (int a = 0; a < 2; ++a)
#pragma unroll
            for (int b = 0; b < 2; ++b)
#pragma unroll
                for (int m = 0; m < 4; ++m)
#pragma unroll
                    for (int n = 0; n < 2; ++n) acc[a][b][m][n] = (f32x4){0.f, 0.f, 0.f, 0.f};
        cur = nxt; cA = nA; cB = nB; ++ui;
        if constexpr (ALIGN_EPI) { if (wr == 1) PG8_BAR; }
    }
    PG8_WAIT_V(0);
    if constexpr (!ALIGN_EPI) { if (wr == 0) PG8_BAR; }
    PG8_BAR;
#undef PG8_SA
#undef PG8_SB
#undef PG8_STAGE
#undef PG8_LDA
#undef PG8_LDB
#undef PG8_MMA
#undef PG8_WAIT_V
#undef PG8_WAIT_L
#undef PG8_BAR
#undef PG8_SCHED
#undef PG8_GROWS
}

__device__ __forceinline__ float clamp448(float v) { return fminf(fmaxf(v, -448.f), 448.f); }
__device__ __forceinline__ unsigned pack4_fp8(float a, float b, float c, float d) {
    int w = __builtin_amdgcn_cvt_pk_fp8_f32(clamp448(a), clamp448(b), 0, false); w = __builtin_amdgcn_cvt_pk_fp8_f32(clamp448(c), clamp448(d), w, true); return (unsigned)w; }
template <int MODE> struct EpiOut {
    static constexpr bool PERM = true;
    bf16_t* O; int ldc; const float* bias; int bstride; float ascale; float oscale;
    __device__ __forceinline__ void operator()(const f32x4 (&acc)[2][2][4][2], const Unit& u, int wr, int wc, int fr, int fq) const {
        const int row0 = u.pm * BM + wr * 64 + fr, col0 = u.pn * BM + wc * 32 + 8 * fq;
        f32x4 bv[2][2]; const float sc = ascale * oscale;
        if constexpr (MODE == 1) {
#pragma unroll
            for (int bj = 0; bj < 2; ++bj)
#pragma unroll
                for (int n = 0; n < 2; ++n) bv[bj][n] = *(const f32x4*)(bias + (size_t)u.e * bstride + col0 + bj * HALF + 4 * n) * oscale;
        }
#pragma unroll
        for (int ai = 0; ai < 2; ++ai)
#pragma unroll
            for (int m = 0; m < 4; ++m) {
#pragma unroll
                for (int bj = 0; bj < 2; ++bj) {
                    if constexpr (MODE == 1) { const f32x4 v0 = acc[ai][bj][m][0] * sc + bv[bj][0], v1 = acc[ai][bj][m][1] * sc + bv[bj][1];
                        typedef unsigned u32x2 __attribute__((ext_vector_type(2))); u32x2 w8; w8.x = pack4_fp8(v0[0], v0[1], v0[2], v0[3]); w8.y = pack4_fp8(v1[0], v1[1], v1[2], v1[3]);
                        *(u32x2*)((unsigned char*)O + (size_t)(row0 + ai * HALF + m * 16) * ldc + col0 + bj * HALF) = w8; }
                    else { const f32x4 v0 = acc[ai][bj][m][0], v1 = acc[ai][bj][m][1];
                        u32x4 w; w.x = cvt_pk_bf16(v0[0], v0[1]); w.y = cvt_pk_bf16(v0[2], v0[3]); w.z = cvt_pk_bf16(v1[0], v1[1]); w.w = cvt_pk_bf16(v1[2], v1[3]);
                        *(u32x4*)(O + (size_t)(row0 + ai * HALF + m * 16) * ldc + col0 + bj * HALF) = w; } } }
    }
};
struct EpiResF32 {
    static constexpr bool PERM = false;
    const float* res; float* out; int ldc;
    __device__ __forceinline__ void operator()(const f32x4 (&acc)[2][2][4][2], const Unit& u, int wr, int wc, int fr, int fq) const {
        const int row0 = u.pm * BM + wr * 64 + fr, col0 = u.pn * BM + wc * 32 + 4 * fq;
#pragma unroll
        for (int ai = 0; ai < 2; ++ai)
#pragma unroll
            for (int m = 0; m < 4; ++m) { const size_t off = (size_t)(row0 + ai * HALF + m * 16) * ldc + col0;
#pragma unroll
                for (int bj = 0; bj < 2; ++bj)
#pragma unroll
                    for (int n = 0; n < 2; ++n) { const f32x4 r = *(const f32x4*)(res + off + bj * HALF + n * 16); *(f32x4*)(out + off + bj * HALF + n * 16) = r + acc[ai][bj][m][n]; } }
    }
};
struct EpiSwiglu {
    static constexpr bool PERM = true;
    bf16_t* O; const float* bglu; const float* blin; const PG8_LAS float* rstdtab;
    float ascale; int out8; float oscale;
    int wt_tiles;
    typedef float f32x2 __attribute__((ext_vector_type(2)));
    __device__ __forceinline__ static f32x2 act2(f32x2 g, f32x2 l, float osc) {
        g = __builtin_elementwise_min(g, (f32x2){7.0f, 7.0f});
        l.x = __builtin_amdgcn_fmed3f(l.x, -7.0f, 7.0f); l.y = __builtin_amdgcn_fmed3f(l.y, -7.0f, 7.0f);
        const f32x2 t = g * -2.4554669596f;
        f32x2 e; e.x = __builtin_amdgcn_exp2f(t.x); e.y = __builtin_amdgcn_exp2f(t.y);
        e = e + 1.0f;
        f32x2 r; r.x = __builtin_amdgcn_rcpf(e.x); r.y = __builtin_amdgcn_rcpf(e.y);
        return (g * r) * (l * osc + osc);
    }
    __device__ __forceinline__ void operator()(const f32x4 (&acc)[2][2][4][2], const Unit& u, int wr, int wc, int fr, int fq) const {
        const int row0 = u.pm * BM + wr * 64 + fr, col0 = u.pn * HALF + wc * 32 + 8 * fq;
        f32x4 bg[2], bl[2];
#pragma unroll
        for (int n = 0; n < 2; ++n) { bg[n] = *(const f32x4*)(bglu + (size_t)u.e * 1024 + col0 + 4 * n); bl[n] = *(const f32x4*)(blin + (size_t)u.e * 1024 + col0 + 4 * n); }
        const float osc = out8 ? oscale : 1.0f; const bool wt = u.pm < wt_tiles;
#pragma unroll
        for (int ai = 0; ai < 2; ++ai)
#pragma unroll
            for (int m = 0; m < 4; ++m) {
                const float rs = rstdtab[u.ui * 256 + ai * HALF + wr * 64 + m * 16 + fr] * ascale;
                float h[8];
#pragma unroll
                for (int n = 0; n < 2; ++n) { const f32x4 gv = acc[ai][0][m][n] * rs + bg[n], lv = acc[ai][1][m][n] * rs + bl[n];
                    const f32x2 h0 = act2((f32x2){gv[0], gv[1]}, (f32x2){lv[0], lv[1]}, osc), h1 = act2((f32x2){gv[2], gv[3]}, (f32x2){lv[2], lv[3]}, osc);
                    h[4 * n] = h0.x; h[4 * n + 1] = h0.y; h[4 * n + 2] = h1.x; h[4 * n + 3] = h1.y; }
                if (out8) { typedef unsigned u32x2 __attribute__((ext_vector_type(2))); u32x2 w8;
                    int w0 = __builtin_amdgcn_cvt_pk_fp8_f32(h[0], h[1], 0, false); w0 = __builtin_amdgcn_cvt_pk_fp8_f32(h[2], h[3], w0, true);
                    int w1 = __builtin_amdgcn_cvt_pk_fp8_f32(h[4], h[5], 0, false); w1 = __builtin_amdgcn_cvt_pk_fp8_f32(h[6], h[7], w1, true);
                    w8.x = (unsigned)w0; w8.y = (unsigned)w1;
                    unsigned char* dp = (unsigned char*)O + (size_t)(row0 + ai * HALF + m * 16) * 1024 + col0;
                    if (wt) __hip_atomic_store((unsigned long long*)dp, ((unsigned long long)w8.y << 32) | w8.x, __ATOMIC_RELAXED, __HIP_MEMORY_SCOPE_AGENT); else *(u32x2*)dp = w8; }
                else { u32x4 w; w.x = cvt_pk_bf16(h[0], h[1]); w.y = cvt_pk_bf16(h[2], h[3]); w.z = cvt_pk_bf16(h[4], h[5]); w.w = cvt_pk_bf16(h[6], h[7]);
                    *(u32x4*)(O + (size_t)(row0 + ai * HALF + m * 16) * 1024 + col0) = w; } }
    }
};
}
#define GAS __attribute__((address_space(1)))
#define LAS __attribute__((address_space(3)))
typedef unsigned v4u __attribute__((ext_vector_type(4)));
typedef float f32x4 __attribute__((ext_vector_type(4)));
typedef short bf16x8 __attribute__((ext_vector_type(8)));
typedef GAS unsigned gu32;
typedef GAS unsigned long long gu64;
#define RLX_AGENT __ATOMIC_RELAXED, __HIP_MEMORY_SCOPE_AGENT
#define LDS_WAIT() asm volatile("s_waitcnt lgkmcnt(0)" ::: "memory")
#define VM_WAIT() asm volatile("s_waitcnt vmcnt(0)" ::: "memory")
__device__ __forceinline__ unsigned long long rt() { return __builtin_amdgcn_s_memrealtime(); }

#define XB_TMO      128
#define XB_XCNT(j)  (256  + 64 * (j))
#define XB_XSUB(j)  (1280 + 64 * (j))
#define XB_XGEN(j)  (2304 + 64 * (j))
#define XB_TOP      3328
#define XB_TOPGEN   3392
#define XCD_BAR_WORDS 3456
#define XB_SPIN_CAP (1u << 18)

__device__ __forceinline__ unsigned xb_ld(unsigned* p)              { return __hip_atomic_load(p, __ATOMIC_RELAXED, __HIP_MEMORY_SCOPE_AGENT); }
__device__ __forceinline__ unsigned xb_add(unsigned* p, unsigned v) { return __hip_atomic_fetch_add(p, v, __ATOMIC_RELAXED, __HIP_MEMORY_SCOPE_AGENT); }
__device__ __forceinline__ unsigned xb_xcc_id() { return (unsigned)__builtin_amdgcn_s_getreg((3 << 11) | 20) & 0xFu; }
#define XB_SPIN(cond, bar) do { unsigned _sp = 0; while (cond) { __builtin_amdgcn_s_sleep(1); \
    if ((++_sp & 255u) == 0u) { if (xb_ld(&(bar)[XB_TMO])) break; if (_sp > XB_SPIN_CAP) { atomicAdd(&(bar)[XB_TMO], 1u); break; } } } } while (0)

struct XcdBarrier {
    unsigned* bar; unsigned x; unsigned total;
    volatile LAS unsigned* st;
};

__device__ __forceinline__ XcdBarrier xcd_barrier_post(unsigned* bar, volatile LAS unsigned* st, unsigned total, bool member) {
    XcdBarrier b; b.bar = bar; b.x = xb_xcc_id(); b.st = st; b.total = total;
    if (member && threadIdx.x == 0) (void)xb_add(&bar[XB_XCNT(b.x)], 1u);
    return b;
}
__device__ __forceinline__ void xcd_barrier_complete(unsigned* bar, unsigned x, unsigned G, unsigned& nloc, unsigned& nx) {
    unsigned sum, cnt, mine, sp = 0u;
    for (;;) {
        sum = 0u; cnt = 0u; mine = 0u;
#pragma unroll
        for (unsigned j = 0; j < 16; ++j) { const unsigned c = xb_ld(&bar[XB_XCNT(j)]); sum += c; cnt += (c > 0u) ? 1u : 0u; mine = (j == x) ? c : mine; }
        if (sum == G) break;
        __builtin_amdgcn_s_sleep(1);
        if ((++sp & 255u) == 0u) { if (xb_ld(&bar[XB_TMO])) break; if (sp > XB_SPIN_CAP) { atomicAdd(&bar[XB_TMO], 1u); break; } }
    }
    nloc = mine > 0u ? mine : 1u; nx = cnt > 0u ? cnt : 1u;
}

__device__ __forceinline__ void xcd_barrier(const XcdBarrier& b) {
    asm volatile("s_waitcnt vmcnt(0)" ::: "memory");
    __syncthreads();
    if (threadIdx.x == 0) {
        unsigned* bar = b.bar;
        __builtin_amdgcn_s_waitcnt(0);
        unsigned nloc = b.st[0], nx = b.st[1];
        if (nloc == 0u) { xcd_barrier_complete(bar, b.x, b.total, nloc, nx); b.st[0] = nloc; b.st[1] = nx; }
        const unsigned old = xb_add(&bar[XB_XSUB(b.x)], 1u);
        const unsigned gen = old / nloc;
        if (old + 1u == (gen + 1u) * nloc) {
            __builtin_amdgcn_fence(__ATOMIC_RELEASE, "agent");
            asm volatile("s_waitcnt vmcnt(0)" ::: "memory");
            const unsigned og = xb_add(&bar[XB_TOP], 1u);
            const unsigned tg = og / nx;
            if (og + 1u == (tg + 1u) * nx) xb_add(&bar[XB_TOPGEN], 1u);
            else XB_SPIN(xb_ld(&bar[XB_TOPGEN]) == tg, bar);
            __builtin_amdgcn_fence(__ATOMIC_ACQUIRE, "agent");
            xb_add(&bar[XB_XGEN(b.x)], 1u);
            asm volatile("s_waitcnt vmcnt(0)" ::: "memory");
        } else {
            XB_SPIN(xb_ld(&bar[XB_XGEN(b.x)]) == gen, bar);
            __builtin_amdgcn_fence(__ATOMIC_ACQUIRE, "agent");
            asm volatile("s_waitcnt vmcnt(0)" ::: "memory");
        }
    }
    __syncthreads();
}
__device__ __forceinline__ int lane_tstart(const int* cnt, int lane, int& mycnt) {
    mycnt = (lane < NE) ? cnt[lane * CNT_STRIDE] : 0;
    const int tiles = (mycnt + 255) >> 8;
    int incl = tiles;
#pragma unroll
    for (int o = 1; o < 64; o <<= 1) { const int v = __shfl_up(incl, o); if (lane >= o) incl += v; }
    return incl - tiles;
}

__device__ __forceinline__ void xn_rows(const float* __restrict__ x, const float* __restrict__ g, bf16* xn, int m0, int stride, int lane) {
    float4 gg[4];
#pragma unroll
    for (int j = 0; j < 4; ++j) gg[j] = ((const float4*)g)[lane + 64 * j];
    for (int m = m0; m < T; m += 2 * stride) {
        const int rowv[2] = {m, (m + stride < T) ? m + stride : m};
        float4 v[2][4];
#pragma unroll
        for (int p = 0; p < 2; ++p) { const float4* xr = (const float4*)(x + (size_t)rowv[p] * D) + lane;
#pragma unroll
            for (int j = 0; j < 4; ++j) v[p][j] = xr[64 * j]; }
#pragma unroll
        for (int p = 0; p < 2; ++p) { float s = 0.f;
#pragma unroll
            for (int j = 0; j < 4; ++j) s += v[p][j].x * v[p][j].x + v[p][j].y * v[p][j].y + v[p][j].z * v[p][j].z + v[p][j].w * v[p][j].w;
            s = wave_sum(s);
            const float r = rsqrtf(s * (1.f / D) + EPS);
            uint2* o = (uint2*)(xn + (size_t)rowv[p] * D) + lane;
#pragma unroll
            for (int j = 0; j < 4; ++j) { uint2 w; w.x = pk2(v[p][j].x * r * gg[j].x, v[p][j].y * r * gg[j].y); w.y = pk2(v[p][j].z * r * gg[j].z, v[p][j].w * r * gg[j].w); o[64 * j] = w; } }
    }
}

__device__ __forceinline__ void combine_rows(const bf16* h16, float* out, const unsigned char* Y8, const int* cnt, const int* sel_e, const float* sel_gate,
                                             const int* sel_pos, const float* __restrict__ g, int m0, int stride, int lane) {
    int mycnt; const int ts = lane_tstart(cnt, lane, mycnt);
    for (int m = m0; m < T; m += 2 * stride) {
        const int rowv[2] = {m, (m + stride < T) ? m + stride : m};
        uint2 aw[2][4]; unsigned yw[2][4][4]; float gs[2][4]; float4 v[2][4];
#pragma unroll
        for (int p = 0; p < 2; ++p) { const int row = rowv[p];
            const uint2* ar = (const uint2*)(h16 + (size_t)row * D) + lane;
#pragma unroll
            for (int j = 0; j < 4; ++j) aw[p][j] = ar[64 * j];
#pragma unroll
            for (int k = 0; k < 4; ++k) { const int e = sel_e[row * 4 + k]; const int pos = sel_pos[row * 4 + k]; gs[p][k] = sel_gate[row * 4 + k] * (1.f / FP8_SY);
                const unsigned* yr = (const unsigned*)(Y8 + (size_t)(256 * __shfl(ts, e) + pos) * D) + lane;
#pragma unroll
                for (int j = 0; j < 4; ++j) yw[p][k][j] = yr[64 * j]; } }
#pragma unroll
        for (int p = 0; p < 2; ++p) { const int row = rowv[p];
            float s = 0.f;
#pragma unroll
            for (int j = 0; j < 4; ++j) { float4 a;
                a.x = __builtin_bit_cast(float, aw[p][j].x << 16); a.y = __builtin_bit_cast(float, aw[p][j].x & 0xffff0000u); a.z = __builtin_bit_cast(float, aw[p][j].y << 16); a.w = __builtin_bit_cast(float, aw[p][j].y & 0xffff0000u);
#pragma unroll
                for (int k = 0; k < 4; ++k) { const f32x2_t lo2 = __builtin_amdgcn_cvt_pk_f32_fp8((int)yw[p][k][j], false), hi2 = __builtin_amdgcn_cvt_pk_f32_fp8((int)yw[p][k][j], true);
                    a.x += gs[p][k] * lo2[0]; a.y += gs[p][k] * lo2[1]; a.z += gs[p][k] * hi2[0]; a.w += gs[p][k] * hi2[1]; }
                s += a.x * a.x + a.y * a.y + a.z * a.z + a.w * a.w; v[p][j] = a; }
            s = wave_sum(s);
            const float r = rsqrtf(s * (1.f / D) + EPS);
            float4* orow = (float4*)(out + (size_t)row * D) + lane;
#pragma unroll
            for (int j = 0; j < 4; ++j) { const float4 gg = ((const float4*)g)[lane + 64 * j];
                float4 w; w.x = v[p][j].x * r * gg.x; w.y = v[p][j].y * r * gg.y; w.z = v[p][j].z * r * gg.z; w.w = v[p][j].w * r * gg.w; orow[64 * j] = w; } }
    }
}

typedef float f32x16 __attribute__((ext_vector_type(16)));
typedef short s16x8 __attribute__((ext_vector_type(8)));
typedef unsigned v2u __attribute__((ext_vector_type(2)));
#define MFMA32(a, b, c) __builtin_amdgcn_mfma_f32_32x32x16_bf16((a), (b), (c), 0, 0, 0)
__device__ __forceinline__ int mrow(int reg, int hh) { return (reg & 3) + 8 * (reg >> 2) + 4 * hh; }
__device__ __forceinline__ v4u pack8(const float (&f)[8]) { v4u w; w.x = pk2(f[0], f[1]); w.y = pk2(f[2], f[3]); w.z = pk2(f[4], f[5]); w.w = pk2(f[6], f[7]); return w; }
__device__ __forceinline__ float bflo(unsigned w) { return __builtin_bit_cast(float, w << 16); }
__device__ __forceinline__ float bfhi(unsigned w) { return __builtin_bit_cast(float, w & 0xffff0000u); }

__device__ __forceinline__ void gla_decay(unsigned zc, const float (&w)[16], float ba, int lane, int wave, LAS unsigned* zl, LAS float* seg, float (&bcs)[8], float& blast) {
    zl[lane] = zc;
    float run = 0.f;
#pragma unroll
    for (int jj = 0; jj < 8; ++jj) {
        const v4u z0 = *(const LAS v4u*)(zl + jj * 8), z1 = *(const LAS v4u*)(zl + jj * 8 + 4);
        float a = ba;
        a += w[0] * bflo(z0.x) + w[1] * bfhi(z0.x) + w[2] * bflo(z0.y) + w[3] * bfhi(z0.y) + w[4] * bflo(z0.z) + w[5] * bfhi(z0.z) + w[6] * bflo(z0.w) + w[7] * bfhi(z0.w);
        a += w[8] * bflo(z1.x) + w[9] * bfhi(z1.x) + w[10] * bflo(z1.y) + w[11] * bfhi(z1.y) + w[12] * bflo(z1.z) + w[13] * bfhi(z1.z) + w[14] * bflo(z1.w) + w[15] * bfhi(z1.w);
        run += logsigmoid_fast(a) * (1.f / 16.f);
        bcs[jj] = run;
    }
    seg[wave * 64 + lane] = run;
    __syncthreads();
    float off = 0.f, tot = 0.f;
#pragma unroll
    for (int w8 = 0; w8 < 8; ++w8) { const float s = seg[w8 * 64 + lane]; tot += s; off += (w8 < wave) ? s : 0.f; }
#pragma unroll
    for (int jj = 0; jj < 8; ++jj) bcs[jj] += off;
    blast = tot;
}
struct T16 { v4u x0, x1; };
__device__ __forceinline__ T16 load_T16(const bf16* src, size_t ld, int lane, int wave) { const v4u* sp = (const v4u*)(src + (size_t)lane * ld + wave * 16); T16 t; t.x0 = sp[0]; t.x1 = sp[1]; return t; }
__device__ __forceinline__ void store_T16(const T16& t, LAS bf16* dst, int lane, int wave) {
    const unsigned w[8] = {t.x0.x, t.x0.y, t.x0.z, t.x0.w, t.x1.x, t.x1.y, t.x1.z, t.x1.w};
    LAS bf16* d = dst + (wave * 16) * 72 + lane;
#pragma unroll
    for (int i = 0; i < 8; ++i) { d[(2 * i) * 72] = (bf16)(w[i] & 0xffffu); d[(2 * i + 1) * 72] = (bf16)(w[i] >> 16); }
}
__device__ __forceinline__ void gla_publish(LAS float* BL, LAS float* BLAST, const float (&bcs)[8], float blast, int lane, int wave) {
#pragma unroll
    for (int jj = 0; jj < 8; ++jj) BL[(wave * 8 + jj) * 68 + lane] = bcs[jj];
    if (wave == 0) BLAST[lane] = blast;
}

struct GlaARaw { v4u kr; T16 vraw; unsigned zc; float wup[16]; float ba; };
__device__ __forceinline__ GlaARaw gla_a_load(int u, const bf16* PROJ, const float* __restrict__ wup, const float* __restrict__ balpha, int lane, int wave) {
    const int bh = u >> 7, c = u & 127, b = bh >> 2, h = bh & 3;
    const bf16* prow0 = PROJ + (size_t)(b * SEQ + c * 64) * DINP;
    GlaARaw w; w.kr = *(const v4u*)(prow0 + (size_t)lane * DINP + C_KA + h * 64 + wave * 8); w.vraw = load_T16(prow0 + C_VA + h * 128, DINP, lane, wave);
    w.zc = *(const unsigned*)(prow0 + (size_t)(wave * 8 + (lane >> 3)) * DINP + C_ZA + 2 * (lane & 7));
#pragma unroll
    for (int r = 0; r < 16; ++r) w.wup[r] = wup[r * 256 + h * 64 + lane];
    w.ba = balpha[h * 64 + lane];
    return w;
}
__device__ __forceinline__ void gla_a_unit(int u, const GlaARaw& w, const bf16* PROJ, const float* __restrict__ wup, const float* __restrict__ balpha, float* KV, float* DECAY, float* BLG,
                                           LAS unsigned char* lds, int tid, int lane, int wave) {
    const int bh = u >> 7, c = u & 127, b = bh >> 2, h = bh & 3;
    const bf16* prow0 = PROJ + (size_t)(b * SEQ + c * 64) * DINP;
    LAS bf16* KT = (LAS bf16*)lds; LAS bf16* VT = (LAS bf16*)(lds + 9216); LAS float* seg = (LAS float*)(lds + 27648);
    LAS float* BL = (LAS float*)(lds + 29696); LAS float* BLAST = (LAS float*)(lds + 47104);
    const v4u kr = w.kr; const T16 vraw = w.vraw;
    float bcs[8], blast;
    gla_decay(w.zc, w.wup, w.ba, lane, wave, (LAS unsigned*)(lds + 47360 + wave * 256), seg, bcs, blast);
    gla_publish(BL, BLAST, bcs, blast, lane, wave);
    if (wave == 0) DECAY[u * 64 + lane] = __expf(blast);
    { float* bg = BLG + (size_t)u * 4096 + (wave * 8) * 64 + lane;
#pragma unroll
      for (int jj = 0; jj < 8; ++jj) bg[jj * 64] = bcs[jj]; }
    __syncthreads();
    {
      const f32x4 b0 = *(const LAS f32x4*)(BL + lane * 68 + wave * 8), b1 = *(const LAS f32x4*)(BL + lane * 68 + wave * 8 + 4);
      const f32x4 l0 = *(const LAS f32x4*)(BLAST + wave * 8), l1 = *(const LAS f32x4*)(BLAST + wave * 8 + 4);
      const unsigned kw[4] = {kr.x, kr.y, kr.z, kr.w};
      LAS bf16* d = KT + (wave * 8) * 72 + lane;
#pragma unroll
      for (int i = 0; i < 4; ++i) { const float e0 = (i < 2 ? l0[2 * i] - b0[2 * i] : l1[2 * i - 4] - b1[2 * i - 4]), e1 = (i < 2 ? l0[2 * i + 1] - b0[2 * i + 1] : l1[2 * i - 3] - b1[2 * i - 3]);
          d[(2 * i) * 72] = (bf16)f2bf(bflo(kw[i]) * __expf(e0)); d[(2 * i + 1) * 72] = (bf16)f2bf(bfhi(kw[i]) * __expf(e1)); } }
    store_T16(vraw, VT, lane, wave);
    __syncthreads();
    const int r = lane & 31, hh = lane >> 5, dt = wave & 1, vt = wave >> 1;
    f32x16 acc = {};
#pragma unroll
    for (int ks = 0; ks < 4; ++ks) {
        const s16x8 a = *(const LAS s16x8*)(KT + (dt * 32 + r) * 72 + ks * 16 + 8 * hh);
        const s16x8 bb = *(const LAS s16x8*)(VT + (vt * 32 + r) * 72 + ks * 16 + 8 * hh);
        acc = MFMA32(a, bb, acc);
    }
    float* kvp = KV + (size_t)u * 8192 + vt * 32 + r;
#pragma unroll
    for (int reg = 0; reg < 16; ++reg) kvp[(dt * 32 + mrow(reg, hh)) * 128] = acc[reg];
    __syncthreads();
}
__device__ __forceinline__ void gla_scan(int id, const float* KV, const float* DECAY, bf16* SPREV) {
    const int bh = id >> 13, dv = id & 8191, d = dv >> 7;
    float S = 0.f;
    const size_t base = (size_t)bh * 128 * 8192 + dv;
#pragma unroll 32
    for (int c = 0; c < 128; ++c) {
        const float kv = KV[base + (size_t)c * 8192];
        const float dec = DECAY[(bh * 128 + c) * 64 + d];
        SPREV[base + (size_t)c * 8192] = (bf16)f2bf(S);
        S = dec * S + kv;
    }
}
struct GlaCRaw { v4u qr, kr; T16 vraw, sraw; v4u rg0, rg1; f32x4 b0, b1; };
__device__ __forceinline__ GlaCRaw gla_c_load(int u, const bf16* PROJ, const float* BLG, const bf16* SPREV, int tid, int lane, int wave) {
    const int bh = u >> 7, c = u & 127, b = bh >> 2, h = bh & 3;
    const size_t row0 = (size_t)b * SEQ + c * 64;
    const bf16* prow0 = PROJ + row0 * DINP;
    GlaCRaw w;
    w.qr = *(const v4u*)(prow0 + (size_t)lane * DINP + C_QA + h * 64 + wave * 8); w.kr = *(const v4u*)(prow0 + (size_t)lane * DINP + C_KA + h * 64 + wave * 8);
    w.vraw = load_T16(prow0 + C_VA + h * 128, DINP, lane, wave); w.sraw = load_T16(SPREV + (size_t)u * 8192, 128, lane, wave);
    const v4u* rp_ = (const v4u*)(PROJ + (row0 + (tid >> 3)) * DINP + C_RA + h * 128 + (tid & 7) * 16);
    w.rg0 = rp_[0]; w.rg1 = rp_[1];
    w.b0 = *(const f32x4*)(BLG + (size_t)u * 4096 + lane * 64 + wave * 8); w.b1 = *(const f32x4*)(BLG + (size_t)u * 4096 + lane * 64 + wave * 8 + 4);
    return w;
}
__device__ __forceinline__ void gla_c_unit(int u, const GlaCRaw& w, const float* __restrict__ gnorm, bf16* CAT, LAS unsigned char* lds, int tid, int lane, int wave) {
    const int bh = u >> 7, c = u & 127, b = bh >> 2, h = bh & 3;
    const size_t row0 = (size_t)b * SEQ + c * 64;
    LAS bf16* QE = (LAS bf16*)lds; LAS bf16* KE = (LAS bf16*)(lds + 9216); LAS bf16* AM = (LAS bf16*)(lds + 18432);
    LAS bf16* VT = (LAS bf16*)(lds + 27648); LAS bf16* ST = (LAS bf16*)(lds + 46080); LAS float* OB = (LAS float*)(lds + 64512);
    const v4u qr = w.qr, kr = w.kr, rg0 = w.rg0, rg1 = w.rg1; const f32x4 b0 = w.b0, b1 = w.b1; const T16 vraw = w.vraw, sraw = w.sraw;
    {
      const unsigned qw[4] = {qr.x, qr.y, qr.z, qr.w}, kw[4] = {kr.x, kr.y, kr.z, kr.w};
      float qe[8], ke[8];
#pragma unroll
      for (int i = 0; i < 4; ++i) { const float ba = (i < 2 ? b0[2 * i] : b1[2 * i - 4]), bb = (i < 2 ? b0[2 * i + 1] : b1[2 * i - 3]);
          const float ea = __expf(ba), eb = __expf(bb);
          qe[2 * i] = bflo(qw[i]) * 0.125f * ea; qe[2 * i + 1] = bfhi(qw[i]) * 0.125f * eb;
          ke[2 * i] = bflo(kw[i]) * __builtin_amdgcn_rcpf(ea); ke[2 * i + 1] = bfhi(kw[i]) * __builtin_amdgcn_rcpf(eb); }
      *(LAS v4u*)(QE + lane * 72 + wave * 8) = pack8(qe); *(LAS v4u*)(KE + lane * 72 + wave * 8) = pack8(ke); }
    store_T16(vraw, VT, lane, wave);
    store_T16(sraw, ST, lane, wave);
    __syncthreads();
    const int r = lane & 31, hh = lane >> 5;
    if (wave < 3) {
        const int it = wave ? 1 : 0, jt = wave == 2 ? 1 : 0;
        f32x16 acc = {};
#pragma unroll
        for (int ks = 0; ks < 4; ++ks) {
            const s16x8 a = *(const LAS s16x8*)(QE + (it * 32 + r) * 72 + ks * 16 + 8 * hh);
            const s16x8 bb = *(const LAS s16x8*)(KE + (jt * 32 + r) * 72 + ks * 16 + 8 * hh);
            acc = MFMA32(a, bb, acc);
        }
        const int j = jt * 32 + r;
#pragma unroll
        for (int reg = 0; reg < 16; ++reg) { const int i = it * 32 + mrow(reg, hh); AM[i * 72 + j] = (bf16)f2bf(j <= i ? acc[reg] : 0.f); }
    } else if (wave == 3) {
#pragma unroll
        for (int reg = 0; reg < 16; ++reg) AM[mrow(reg, hh) * 72 + 32 + r] = 0;
    }
    __syncthreads();
    { const int it = wave & 1, vt = wave >> 1;
      f32x16 acc = {};
#pragma unroll
      for (int ks = 0; ks < 4; ++ks) {
          const s16x8 a = *(const LAS s16x8*)(AM + (it * 32 + r) * 72 + ks * 16 + 8 * hh);
          const s16x8 bb = *(const LAS s16x8*)(VT + (vt * 32 + r) * 72 + ks * 16 + 8 * hh);
          acc = MFMA32(a, bb, acc);
      }
#pragma unroll
      for (int ks = 0; ks < 4; ++ks) {
          const s16x8 a = *(const LAS s16x8*)(QE + (it * 32 + r) * 72 + ks * 16 + 8 * hh);
          const s16x8 bb = *(const LAS s16x8*)(ST + (vt * 32 + r) * 72 + ks * 16 + 8 * hh);
          acc = MFMA32(a, bb, acc);
      }
#pragma unroll
      for (int reg = 0; reg < 16; ++reg) OB[(it * 32 + mrow(reg, hh)) * 132 + vt * 32 + r] = acc[reg]; }
    __syncthreads();
    { const int i = tid >> 3, s8 = tid & 7;
      float o[16]; float ss = 0.f;
#pragma unroll
      for (int q4 = 0; q4 < 4; ++q4) { const f32x4 t4 = *(const LAS f32x4*)(OB + i * 132 + s8 * 16 + q4 * 4); o[4 * q4] = t4[0]; o[4 * q4 + 1] = t4[1]; o[4 * q4 + 2] = t4[2]; o[4 * q4 + 3] = t4[3]; }
#pragma unroll
      for (int q = 0; q < 16; ++q) ss += o[q] * o[q];
      ss += __shfl_xor(ss, 1); ss += __shfl_xor(ss, 2); ss += __shfl_xor(ss, 4);
      const float rstd = rsqrtf(ss * (1.f / 128.f) + EPS);
      const unsigned rw[8] = {rg0.x, rg0.y, rg0.z, rg0.w, rg1.x, rg1.y, rg1.z, rg1.w};
      float res[16];
#pragma unroll
      for (int q = 0; q < 8; ++q) { const float ra = bflo(rw[q]), rb = bfhi(rw[q]);
          res[2 * q] = o[2 * q] * rstd * gnorm[s8 * 16 + 2 * q] * (ra * __builtin_amdgcn_rcpf(1.f + __builtin_amdgcn_exp2f(-1.4426950408889634f * ra)));
          res[2 * q + 1] = o[2 * q + 1] * rstd * gnorm[s8 * 16 + 2 * q + 1] * (rb * __builtin_amdgcn_rcpf(1.f + __builtin_amdgcn_exp2f(-1.4426950408889634f * rb))); }
      uint4 w0, w1;
      w0.x = pk2(res[0], res[1]); w0.y = pk2(res[2], res[3]); w0.z = pk2(res[4], res[5]); w0.w = pk2(res[6], res[7]);
      w1.x = pk2(res[8], res[9]); w1.y = pk2(res[10], res[11]); w1.z = pk2(res[12], res[13]); w1.w = pk2(res[14], res[15]);
      uint4* op = (uint4*)(CAT + (row0 + i) * D + h * 128 + s8 * 16);
      op[0] = w0; op[1] = w1; }
    __syncthreads();
}

struct SwaRaw { v4u k[3], v[3]; s16x8 qf[4]; };
__device__ __forceinline__ SwaRaw swa_load(int s, const bf16* PROJ, int tid, int lane, int wave) {
    const int b = s >> 8, kvh = (s >> 7) & 1, qt = s & 127, q0 = qt * 64;
    const size_t rowb = (size_t)b * SEQ;
    SwaRaw w;
#pragma unroll
    for (int i = 0; i < 3; ++i) { const int id = tid + 512 * i, kk = id >> 3, ch = id & 7; int tok = q0 - 128 + kk; tok = tok < 0 ? 0 : tok;
        w.k[i] = *(const v4u*)(PROJ + (rowb + tok) * DINP + C_KB + kvh * 64 + ch * 8); }
#pragma unroll
    for (int g3 = 0; g3 < 3; ++g3) { int tok = q0 - 128 + 64 * g3 + lane; tok = tok < 0 ? 0 : tok;
        w.v[g3] = *(const v4u*)(PROJ + (rowb + tok) * DINP + C_VB + kvh * 64 + wave * 8); }
    const int r = lane & 31, hh = lane >> 5, g = wave >> 1, half = wave & 1, hq = kvh * 4 + g;
    const bf16* qp = PROJ + (rowb + q0 + half * 32 + r) * DINP + C_QB + hq * 64 + 8 * hh;
#pragma unroll
    for (int ks = 0; ks < 4; ++ks) w.qf[ks] = *(const s16x8*)(qp + ks * 16);
    return w;
}
__device__ __forceinline__ void swa_unit(int s, const SwaRaw& w, const float* __restrict__ sinks, const float* __restrict__ gnorm, bf16* CAT,
                                         LAS unsigned char* lds, int tid, int lane, int wave) {
    const int b = s >> 8, kvh = (s >> 7) & 1, qt = s & 127, q0 = qt * 64;
    const size_t rowb = (size_t)b * SEQ;
    LAS bf16* KS = (LAS bf16*)lds; LAS bf16* VT = (LAS bf16*)(lds + 27648); LAS bf16* STG = (LAS bf16*)(lds + 53248 + wave * 4608);
#pragma unroll
    for (int i = 0; i < 3; ++i) { const int id = tid + 512 * i, kk = id >> 3, ch = id & 7; *(LAS v4u*)(KS + kk * 72 + ch * 8) = w.k[i]; }
#pragma unroll
    for (int g3 = 0; g3 < 3; ++g3) { const int kk = 64 * g3 + lane; const unsigned wv[4] = {w.v[g3].x, w.v[g3].y, w.v[g3].z, w.v[g3].w};
        LAS bf16* d = VT + (wave * 8) * 200 + kk;
#pragma unroll
        for (int i = 0; i < 4; ++i) { d[(2 * i) * 200] = (bf16)(wv[i] & 0xffffu); d[(2 * i + 1) * 200] = (bf16)(wv[i] >> 16); } }
    const int r = lane & 31, hh = lane >> 5, g = wave >> 1, half = wave & 1, hq = kvh * 4 + g;
    s16x8 qf[4];
#pragma unroll
    for (int ks = 0; ks < 4; ++ks) qf[ks] = w.qf[ks];
    __syncthreads();
    const float L2E = 1.4426950408889634f;
    const float slope2 = exp2f(-(float)(hq + 1)) * L2E, sink2 = sinks[hq] * L2E;
    const int rl = r - 4 * hh, kmin = 128 - q0 - 32 * half - 4 * hh;
    const float fbl = slope2 * (float)rl;
    float m = sink2;
    f32x16 sc[5];
#pragma unroll
    for (int blk = 0; blk < 5; ++blk) { sc[blk] = (f32x16){};
#pragma unroll
        for (int ks = 0; ks < 4; ++ks) { const s16x8 a = *(const LAS s16x8*)(KS + (32 * (half + blk) + r) * 72 + ks * 16 + 8 * hh); sc[blk] = MFMA32(a, qf[ks], sc[blk]); }
        if (blk >= 1 && blk <= 3 && q0 >= 128) {
#pragma unroll
            for (int reg = 0; reg < 16; ++reg) { const int c1 = 128 - (32 * blk + (reg & 3) + 8 * (reg >> 2));
                const float v = fmaf(sc[blk][reg], 0.125f * L2E, -(fbl + slope2 * (float)c1));
                sc[blk][reg] = v; m = fmaxf(m, v); }
        } else {
#pragma unroll
            for (int reg = 0; reg < 16; ++reg) { const int c2 = 32 * blk + (reg & 3) + 8 * (reg >> 2), c1 = 128 - c2;
                const bool valid = ((unsigned)(rl + c1) < 128u) && (c2 >= kmin);
                const float v = valid ? fmaf(sc[blk][reg], 0.125f * L2E, -(fbl + slope2 * (float)c1)) : -INFINITY;
                sc[blk][reg] = v; m = fmaxf(m, v); }
        }
        __builtin_amdgcn_sched_barrier(0);
    }
    m = fmaxf(m, __shfl_xor(m, 32));
    float l = 0.f;
    f32x16 o[2]; o[0] = (f32x16){}; o[1] = (f32x16){};
#pragma unroll
    for (int blk = 0; blk < 5; ++blk) {
        float p[16];
#pragma unroll
        for (int reg = 0; reg < 16; ++reg) { p[reg] = __builtin_amdgcn_exp2f(sc[blk][reg] - m); l += p[reg]; }
#pragma unroll
        for (int s2 = 0; s2 < 2; ++s2) {
            v4u pw; pw.x = pk2(p[8 * s2], p[8 * s2 + 1]); pw.y = pk2(p[8 * s2 + 2], p[8 * s2 + 3]); pw.z = pk2(p[8 * s2 + 4], p[8 * s2 + 5]); pw.w = pk2(p[8 * s2 + 6], p[8 * s2 + 7]);
            const s16x8 pf = __builtin_bit_cast(s16x8, pw);
            const int base = 32 * (half + blk) + 16 * s2 + 4 * hh;
#pragma unroll
            for (int db = 0; db < 2; ++db) {
                const v2u lo = *(const LAS v2u*)(VT + (db * 32 + r) * 200 + base), hi = *(const LAS v2u*)(VT + (db * 32 + r) * 200 + base + 8);
                v4u aw; aw.x = lo.x; aw.y = lo.y; aw.z = hi.x; aw.w = hi.y;
                o[db] = MFMA32(__builtin_bit_cast(s16x8, aw), pf, o[db]);
            }
        }
        __builtin_amdgcn_sched_barrier(0);
    }
    l += __shfl_xor(l, 32);
    l += __builtin_amdgcn_exp2f(sink2 - m);
    const float inv_l = 1.f / l;
    float ss = 0.f;
#pragma unroll
    for (int db = 0; db < 2; ++db)
#pragma unroll
        for (int reg = 0; reg < 16; ++reg) { o[db][reg] *= inv_l; ss += o[db][reg] * o[db][reg]; }
    ss += __shfl_xor(ss, 32);
    const float rstd = rsqrtf(ss * (1.f / 64.f) + EPS);
#pragma unroll
    for (int db = 0; db < 2; ++db)
#pragma unroll
        for (int rq = 0; rq < 4; ++rq) { const float4 gg = *(const float4*)(gnorm + db * 32 + 8 * rq + 4 * hh);
            const int dv = db * 32 + 8 * rq + 4 * hh;
            STG[r * 72 + dv + 0] = (bf16)f2bf(o[db][4 * rq + 0] * rstd * gg.x); STG[r * 72 + dv + 1] = (bf16)f2bf(o[db][4 * rq + 1] * rstd * gg.y);
            STG[r * 72 + dv + 2] = (bf16)f2bf(o[db][4 * rq + 2] * rstd * gg.z); STG[r * 72 + dv + 3] = (bf16)f2bf(o[db][4 * rq + 3] * rstd * gg.w); }
    asm volatile("s_waitcnt lgkmcnt(0)" ::: "memory");
#pragma unroll
    for (int it = 0; it < 4; ++it) { const int q = (lane >> 3) + 8 * it, ch = lane & 7;
        const v4u v = *(const LAS v4u*)(STG + q * 72 + ch * 8);
        *(v4u*)(CAT + (rowb + q0 + half * 32 + q) * D + 512 + hq * 64 + ch * 8) = v; }
    __syncthreads();
}

__device__ __forceinline__ void router_block(int blk, const float* __restrict__ X, bf16* ATT  , const float* __restrict__ g2, const bf16* WRH, const bf16* WRL, const float* __restrict__ br,
                                             bf16* HN, float* RSTD, int* cnt, int* tok_list, int* sel_e, float* sel_gate, int* sel_pos,
                                             LAS unsigned char* lds, int tid, int lane, int wave) {
#ifdef RPROBE
    const unsigned long long rp0_ = __builtin_amdgcn_s_memrealtime(); unsigned long long rp1_ = 0, rp2_ = 0;
#endif
    LAS unsigned char* reg_w = lds + wave * 16384;
    const int r = lane & 31, hh = lane >> 5, t = wave >> 2, q = wave & 3;
    const size_t row0 = (size_t)blk * 64 + t * 32;
    const int c4 = 4 * r;
    f32x16 acc = {};
    float sq[16];
#pragma unroll
    for (int i = 0; i < 16; ++i) sq[i] = 0.f;
#pragma unroll 1
    for (int sc = 0; sc < 2; ++sc) {
        const int kb = q * 256 + sc * 128;
        const float4 gg = *(const float4*)(g2 + kb + c4);
#pragma unroll
        for (int hb = 0; hb < 2; ++hb) {
            float4 xv[8]; uint2 av[8];
#pragma unroll
            for (int i = 0; i < 8; ++i) { const size_t grow = row0 + 2 * (8 * hb + i) + hh; xv[i] = *(const float4*)(X + grow * D + kb + c4); av[i] = *(const uint2*)(ATT + grow * D + kb + c4); }
#pragma unroll
            for (int i = 0; i < 8; ++i) {
                const int rw = 2 * (8 * hb + i) + hh; const size_t grow = row0 + rw;
                float4 h = xv[i]; const uint2 aw = av[i];
                h.x += bflo(aw.x); h.y += bfhi(aw.x); h.z += bflo(aw.y); h.w += bfhi(aw.y);
                sq[8 * hb + i] += h.x * h.x + h.y * h.y + h.z * h.z + h.w * h.w;
                { uint2 hw; hw.x = pk2(h.x, h.y); hw.y = pk2(h.z, h.w); *(uint2*)(ATT + grow * D + kb + c4) = hw; }
                const float x0 = h.x * gg.x, x1 = h.y * gg.y, x2 = h.z * gg.z, x3 = h.w * gg.w;
                v2u vh, vl; vh.x = pk2(x0, x1); vh.y = pk2(x2, x3);
                vl.x = pk2(x0 - bflo(vh.x), x1 - bfhi(vh.x)); vl.y = pk2(x2 - bflo(vh.y), x3 - bfhi(vh.y));
                const int off = rw * 256 + (((r >> 1) ^ (rw & 15)) << 4) + ((r & 1) << 3);
                *(LAS v2u*)(reg_w + off) = vh; *(LAS v2u*)(reg_w + 8192 + off) = vl;
#if MOE_FP8
                *(unsigned*)((unsigned char*)HN + grow * D + kb + c4) = pg8::pack4_fp8(x0 * FP8_SA, x1 * FP8_SA, x2 * FP8_SA, x3 * FP8_SA);
#else
                *(v2u*)(HN + grow * D + kb + c4) = vh;
#endif
            }
        }
#pragma unroll
        for (int ks = 0; ks < 8; ++ks) {
            const int off = r * 256 + (((2 * ks + hh) ^ (r & 15)) << 4);
            const s16x8 fh = *(const LAS s16x8*)(reg_w + off), fl = *(const LAS s16x8*)(reg_w + 8192 + off);
            const s16x8 wh = *(const s16x8*)(WRH + (size_t)r * D + kb + ks * 16 + 8 * hh), wl = *(const s16x8*)(WRL + (size_t)r * D + kb + ks * 16 + 8 * hh);
            acc = MFMA32(fh, wh, acc); acc = MFMA32(fh, wl, acc); acc = MFMA32(fl, wh, acc);
        }
    }
    { const bool b4 = r & 16, b3 = r & 8, b2 = r & 4, b1 = r & 2;
      float s8[8], s4[4], s2[2], s1;
#pragma unroll
      for (int j = 0; j < 8; ++j) s8[j] = (b4 ? sq[j + 8] : sq[j]) + __shfl_xor(b4 ? sq[j] : sq[j + 8], 16);
#pragma unroll
      for (int j = 0; j < 4; ++j) s4[j] = (b3 ? s8[j + 4] : s8[j]) + __shfl_xor(b3 ? s8[j] : s8[j + 4], 8);
#pragma unroll
      for (int j = 0; j < 2; ++j) s2[j] = (b2 ? s4[j + 2] : s4[j]) + __shfl_xor(b2 ? s4[j] : s4[j + 2], 4);
      s1 = (b1 ? s2[1] : s2[0]) + __shfl_xor(b1 ? s2[0] : s2[1], 2);
      s1 += __shfl_xor(s1, 1);
      const int i = (b4 ? 8 : 0) + (b3 ? 4 : 0) + (b2 ? 2 : 0) + (b1 ? 1 : 0);
      LAS float* SQw = (LAS float*)(reg_w + 4096);
      if (!(r & 1)) SQw[2 * i + hh] = s1; }
    { LAS float* PARTw = (LAS float*)reg_w;
#pragma unroll
      for (int reg = 0; reg < 16; ++reg) PARTw[mrow(reg, hh) * 32 + r] = acc[reg]; }
    __syncthreads();
#ifdef RPROBE
    rp1_ = __builtin_amdgcn_s_memrealtime();
#endif
#define PART_AT(w_, m_, e_) (*(const LAS float*)(lds + (w_) * 16384 + ((m_) * 32 + (e_)) * 4))
#define SQ_AT(w_, m_) (*(const LAS float*)(lds + (w_) * 16384 + 4096 + (m_) * 4))
    LAS int* lcnt = (LAS int*)(lds + 8192); LAS int* lbase = lcnt + 32;
    if (tid < 32) lcnt[tid] = 0;
    __syncthreads();
    int s_ex[4], s_lp[4]; float s_gt[4];
#pragma unroll
    for (int it = 0; it < 4; ++it) {
        const int rl = wave * 8 + it * 2 + hh, tt = rl >> 5, m = rl & 31, e = r;
        float lg = 0.f, ss = 0.f;
#pragma unroll
        for (int qq = 0; qq < 4; ++qq) { lg += PART_AT(tt * 4 + qq, m, e); ss += SQ_AT(tt * 4 + qq, m); }
        const float rstd = rsqrtf(ss * (1.f / D) + EPS);
        float cur = lg * rstd + br[e];
        float tv[4]; int ti[4];
#pragma unroll
        for (int k = 0; k < 4; ++k) {
            float mx = cur;
#pragma unroll
            for (int o = 1; o < 32; o <<= 1) mx = fmaxf(mx, __shfl_xor(mx, o));
            int idx = (cur == mx) ? e : 99;
#pragma unroll
            for (int o = 1; o < 32; o <<= 1) idx = min(idx, __shfl_xor(idx, o));
            tv[k] = mx; ti[k] = idx;
            if (e == idx) cur = -INFINITY;
        }
        const float e1 = __expf(tv[1] - tv[0]), e2 = __expf(tv[2] - tv[0]), e3 = __expf(tv[3] - tv[0]);
        const float inv = 1.f / (1.f + e1 + e2 + e3);
        s_ex[it] = e == 0 ? ti[0] : e == 1 ? ti[1] : e == 2 ? ti[2] : ti[3];
        s_gt[it] = (e == 0 ? 1.f : e == 1 ? e1 : e == 2 ? e2 : e3) * inv;
        s_lp[it] = 0;
        if (e < 4) s_lp[it] = __hip_atomic_fetch_add(&lcnt[s_ex[it]], 1, __ATOMIC_RELAXED, __HIP_MEMORY_SCOPE_WORKGROUP);
        if (e == 4) RSTD[blk * 64 + rl] = rstd;
    }
    __syncthreads();
#ifdef RPROBE
    rp2_ = __builtin_amdgcn_s_memrealtime();
#endif
    if (tid < 32) { const int n = lcnt[tid]; lbase[tid] = n ? atomicAdd(&cnt[tid * CNT_STRIDE], n) : 0; }
    __syncthreads();
    if (r < 4) {
#pragma unroll
        for (int it = 0; it < 4; ++it) { const int grow = blk * 64 + wave * 8 + it * 2 + hh, pos = lbase[s_ex[it]] + s_lp[it];
            tok_list[s_ex[it] * T + pos] = grow;
            sel_e[grow * 4 + r] = s_ex[it]; sel_gate[grow * 4 + r] = s_gt[it]; sel_pos[grow * 4 + r] = pos; }
    }
    __syncthreads();
#ifdef RPROBE
    if (blockIdx.x == 0 && tid == 0) { const unsigned long long rp3_ = __builtin_amdgcn_s_memrealtime(); const unsigned long long seg_[3] = {rp1_ - rp0_, rp2_ - rp1_, rp3_ - rp2_};
        const unsigned long long dt = seg_[RPROBE] * 9ull, t0 = __builtin_amdgcn_s_memrealtime(); while (__builtin_amdgcn_s_memrealtime() - t0 < dt) __builtin_amdgcn_s_sleep(8); }
#endif
}
constexpr int NWAVES = 8;
constexpr int RING_BYTES = 131072;
constexpr int LDSCTL_OFF = RING_BYTES, MISC_OFF = LDSCTL_OFF + 320;
constexpr int TAB_OFF = RING_BYTES + 1024;
constexpr int ROWS_OFF = TAB_OFF + 512;
constexpr int LDS_BYTES = 163840, ROWTABS = 14;
constexpr int RSTD_OFF = ROWS_OFF + ROWTABS * 1024;
static_assert(RSTD_OFF + ROWTABS * 1024 <= LDS_BYTES, "LDS map");

#ifndef MOE_W_ITEMS
#define MOE_W_ITEMS 20480
#endif
enum Phase { PH_PROLOGUE = 0, PH_INPROJ, PH_GLA_A, PH_SCAN, PH_GLA_C, PH_OUTPROJ, PH_ROUTER, PH_MOE1, PH_MOE2, PH_COMBINE, PH_N };

struct Args { const float* in[19]; float* out; unsigned char* ws; int ph_lo, ph_hi, li, pad; };

struct GridOrder {
    int nN, nunits, G, v;
    __device__ __forceinline__ bool next(int i, pg8::Unit& u) const {
        const int L = i * G + v; if (L >= nunits) return false;
        const int gs = 8 * nN, grp = L / gs, rem = L % gs;
        u.pm = grp * 8 + (rem & 7); u.pn = rem >> 3; u.am = u.pm; u.bn = u.pn; u.e = 0; u.ui = i; u.skip = 0; u.kind = 0; return true;
    }
    __device__ __forceinline__ const LAS int* rows(int) const { return nullptr; }
    __device__ __forceinline__ const char* abase(const pg8::Unit&) const { return nullptr; }
    __device__ __forceinline__ const char* bbase(const pg8::Unit&, size_t) const { return nullptr; }
    __device__ __forceinline__ void a_ready(const pg8::Unit&) const {}
    __device__ __forceinline__ void done(const pg8::Unit&) const {}
};
struct MoeOrder {
    const LAS int* tstart; const LAS int* rowtab; int ncol, ntile, G, v;
    __device__ __forceinline__ static int expert_of(const LAS int* ts, int R) { int e = 0;
#pragma unroll
        for (int j = 1; j < NE; ++j) e += (ts[j] <= R) ? 1 : 0;
        return e; }
    __device__ __forceinline__ bool map(int i, int& R, int& pn) const {
        const int li = i * G + v; if (li >= ntile * ncol) return false;
        R = li / ncol; pn = li % ncol; return true;
    }
    __device__ __forceinline__ bool next(int i, pg8::Unit& u) const {
        int R, pn; if (!map(i, R, pn)) return false;
        u.pm = R; u.pn = pn; u.am = R; u.e = expert_of(tstart, R); u.bn = u.e * ncol + pn; u.ui = i; u.skip = 0; u.kind = 0;
        return true;
    }
    __device__ __forceinline__ const LAS int* rows(int ui) const { return rowtab + ui * 256; }
    __device__ __forceinline__ const char* abase(const pg8::Unit&) const { return nullptr; }
    __device__ __forceinline__ const char* bbase(const pg8::Unit&, size_t) const { return nullptr; }
    __device__ __forceinline__ void a_ready(const pg8::Unit&) const {}
    __device__ __forceinline__ void done(const pg8::Unit&) const {}
};

struct P0Item { const float* W; unsigned char* WT; int ldw, ncols, k0, n0, dst_row0; };
__device__ __forceinline__ void p0_load(const P0Item& t, float4 (&v)[8], int lane) {
    const int c = t.n0 + 4 * (lane & 7);
#pragma unroll
    for (int i = 0; i < 8; ++i) { const int kk = (lane >> 3) + 8 * i; v[i] = (c < t.ncols) ? *(const float4*)(t.W + (size_t)(t.k0 + kk) * t.ldw + c) : make_float4(0.f, 0.f, 0.f, 0.f); }
}
template <bool F8> __device__ __forceinline__ void p0_finish(const P0Item& t, const float4 (&v)[8], LAS float* scr, int lane) {
#pragma unroll
    for (int i = 0; i < 8; ++i) { LAS float* d = scr + ((lane >> 3) + 8 * i) * 33 + 4 * (lane & 7); d[0] = v[i].x; d[1] = v[i].y; d[2] = v[i].z; d[3] = v[i].w; }
    LDS_WAIT(); asm volatile("" ::: "memory");
    const int c8 = lane & 7;
#pragma unroll
    for (int j = 0; j < 4; ++j) { const int n = (lane >> 3) + 8 * j; const LAS float* s = scr + (8 * c8) * 33 + n;
        if constexpr (F8) { typedef unsigned u32x2 __attribute__((ext_vector_type(2))); u32x2 o8;
            o8.x = pg8::pack4_fp8(s[0 * 33] * FP8_SW, s[1 * 33] * FP8_SW, s[2 * 33] * FP8_SW, s[3 * 33] * FP8_SW); o8.y = pg8::pack4_fp8(s[4 * 33] * FP8_SW, s[5 * 33] * FP8_SW, s[6 * 33] * FP8_SW, s[7 * 33] * FP8_SW);
            *(u32x2*)(t.WT + (size_t)(t.dst_row0 + n) * 1024 + t.k0 + 8 * c8) = o8; }
        else { v4u o; o.x = pk2(s[0 * 33], s[1 * 33]); o.y = pk2(s[2 * 33], s[3 * 33]); o.z = pk2(s[4 * 33], s[5 * 33]); o.w = pk2(s[6 * 33], s[7 * 33]);
            *(v4u*)((bf16*)t.WT + (size_t)(t.dst_row0 + n) * 1024 + t.k0 + 8 * c8) = o; } }
    LDS_WAIT(); asm volatile("" ::: "memory");
}
constexpr int P0_IN_ITEMS = 16 * 80, P0_OUT_ITEMS = 16 * 32, P0_SMALL_ITEMS = P0_IN_ITEMS + P0_OUT_ITEMS, P0_EXP_ITEMS = 3 * 512, P0_MOE_ITEMS = NE * P0_EXP_ITEMS;
__device__ __forceinline__ P0Item p0_small_item(const Args& a, int it) {
    if (it < P0_IN_ITEMS) { const int kb = it / 80, nb = it % 80; return P0Item{a.in[2], a.ws + WS_WIN, DIN, DIN, 64 * kb, 32 * nb, 32 * nb}; }
    it -= P0_IN_ITEMS; const int kb = it / 32, nb = it % 32; return P0Item{a.in[8], a.ws + WS_WOUT, D, D, 64 * kb, 32 * nb, 32 * nb};
}
__device__ __forceinline__ P0Item p0_moe_item(const Args& a, int it) {
    constexpr int EB = MOE_FP8 ? 1 : 2;
    const int e = it / P0_EXP_ITEMS, r = it % P0_EXP_ITEMS, mat = r / 512, r2 = r % 512, kb = r2 / 32, n0 = 32 * (r2 % 32);
    if (mat == 2) return P0Item{a.in[16] + (size_t)e * D * D, a.ws + WS_WD + (size_t)e * D * D * EB, D, D, 64 * kb, n0, n0};
    return P0Item{(mat == 0 ? a.in[12] : a.in[14]) + (size_t)e * D * D, a.ws + WS_WGL + (size_t)e * 2 * D * D * EB, D, D, 64 * kb, n0, (n0 >> 7) * 256 + (n0 & 127) + (mat == 1 ? 128 : 0)};
}
__device__ __forceinline__ void p0_moe_stream(const Args& a, int first, int last, int w, int nw, LAS float* scr, int lane) {
    float4 va[8], vb[8], vc[8];
    int it = first + w;
    if (it < last) p0_load(p0_moe_item(a, it), va, lane);
    if (it + nw < last) p0_load(p0_moe_item(a, it + nw), vb, lane);
    for (; it < last; it += 3 * nw) {
        if (it + 2 * nw < last) p0_load(p0_moe_item(a, it + 2 * nw), vc, lane);
        p0_finish<MOE_FP8 != 0>(p0_moe_item(a, it), va, scr, lane);
        if (it + 3 * nw < last) p0_load(p0_moe_item(a, it + 3 * nw), va, lane);
        if (it + nw < last) p0_finish<MOE_FP8 != 0>(p0_moe_item(a, it + nw), vb, scr, lane);
        if (it + 4 * nw < last) p0_load(p0_moe_item(a, it + 4 * nw), vb, lane);
        if (it + 2 * nw < last) p0_finish<MOE_FP8 != 0>(p0_moe_item(a, it + 2 * nw), vc, scr, lane);
    }
}

__global__ void __launch_bounds__(NWAVES * 64, 2) mk_fwd(Args args) {
    extern __shared__ __attribute__((aligned(16))) unsigned char lds_raw[];
    LAS unsigned char* lds = (LAS unsigned char*)lds_raw;
    volatile LAS unsigned* MISC = (volatile LAS unsigned*)(lds + MISC_OFF);
    const int tid = threadIdx.x, lane = tid & 63, wave = __builtin_amdgcn_readfirstlane(tid >> 6);
    const int G = gridDim.x; int vcu; { const int bx = blockIdx.x; vcu = (G % 8 == 0) ? (bx % 8) * (G / 8) + bx / 8 : bx; }
    unsigned char* ws = args.ws;
    unsigned* ctl = (unsigned*)(ws + WS_CTL);
    for (int u = tid; u < (LDS_BYTES - LDSCTL_OFF) / 4; u += NWAVES * 64) ((LAS unsigned*)(lds + LDSCTL_OFF))[u] = 0u;
    __syncthreads();
    const int lo = args.ph_lo, hi = args.ph_hi;
#define IN(k) (lo <= (k) && (k) < hi)
#ifdef TPROBE
    unsigned long long tp_[PH_N + 1]; tp_[0] = __builtin_amdgcn_s_memrealtime();
#define TSTAMP(k) tp_[(k) + 1] = __builtin_amdgcn_s_memrealtime()
#else
#define TSTAMP(k) do {} while (0)
#endif
#ifndef NWK_PER_XCD
#define NWK_PER_XCD 27
#endif
    constexpr int NWK = NWK_PER_XCD;
        const bool split = (lo == 0 && hi == PH_N && G == 256);
    const bool conv = split && (vcu & 31) >= NWK;
    const int wi = split ? (vcu >> 5) * NWK + (vcu & 31) : vcu, WG = split ? 8 * NWK : G;
    XcdBarrier barW = xcd_barrier_post(ctl + CW_BAR + (2 * args.li) * XCD_BAR_WORDS, MISC + 8, (unsigned)WG, split && !conv);
    XcdBarrier barA = xcd_barrier_post(ctl + CW_BAR + (2 * args.li + 1) * XCD_BAR_WORDS, MISC + 12, (unsigned)G, true);
#define SEAM(k) do { if (IN(k) && IN((k) + 1)) { if (split && (k) < PH_GLA_C) xcd_barrier(barW); else xcd_barrier(barA); } } while (0)
    const int gw = vcu * NWAVES + wave, NGW = G * NWAVES;
    const int gww = wi * NWAVES + wave, NGWW = WG * NWAVES;
    LAS float* scr = (LAS float*)(lds + wave * 16384);
    constexpr int MOE_ITEMS_BY_WORKERS = MOE_W_ITEMS;

    if (conv) {
        const int cw = ((vcu >> 5) * (32 - NWK) + ((vcu & 31) - NWK)) * NWAVES + wave, ncw = 8 * (32 - NWK) * NWAVES;
        p0_moe_stream(args, MOE_ITEMS_BY_WORKERS, P0_MOE_ITEMS, cw, ncw, scr, lane);
    } else {
    if (IN(PH_PROLOGUE)) {
        for (int it = gww; it < P0_SMALL_ITEMS; it += NGWW) { float4 v[8]; const P0Item t = p0_small_item(args, it); p0_load(t, v, lane); p0_finish<false>(t, v, scr, lane); }
        p0_moe_stream(args, 0, split ? MOE_ITEMS_BY_WORKERS : P0_MOE_ITEMS, gww, NGWW, scr, lane);
        xn_rows(args.in[0], args.in[1], (bf16*)(ws + WS_XN), gww, NGWW, lane);
        for (int idx = (wi * NWAVES * 64) + tid; idx < NE * D; idx += WG * NWAVES * 64) { const int e = idx >> 10, k = idx & 1023; const float x = args.in[10][k * NE + e];
            const unsigned hi_ = f2bf(x); ((bf16*)(ws + WS_WRH))[idx] = (bf16)hi_; ((bf16*)(ws + WS_WRL))[idx] = (bf16)f2bf(x - __builtin_bit_cast(float, hi_ << 16)); }
    }
    SEAM(PH_PROLOGUE); TSTAMP(PH_PROLOGUE);
    if (IN(PH_INPROJ)) {
        pg8::Gemm g{(const bf16*)(ws + WS_XN), (const bf16*)(ws + WS_WIN), D};
        GridOrder S{DINP / 256, (T / 256) * (DINP / 256), WG, wi};
        pg8::EpiOut<0> E{(bf16*)(ws + WS_PROJ), DINP, nullptr, 0, 1.f, 1.f};
        pg8::gemm_phase<pg8::EpiOut<0>, GridOrder, true, false>(lds, g, S, E);
    }
    SEAM(PH_INPROJ); TSTAMP(PH_INPROJ);
    if (IN(PH_GLA_A)) {
        const bf16* PROJp = (const bf16*)(ws + WS_PROJ);
        {
            int U = wi; SwaRaw cur; if (U < 512) cur = swa_load(U, PROJp, tid, lane, wave);
            for (; U < 512; U += WG) { SwaRaw nxt; const bool hn = U + WG < 512; if (hn) nxt = swa_load(U + WG, PROJp, tid, lane, wave);
                swa_unit(U, cur, args.in[6], args.in[7], (bf16*)(ws + WS_CAT), lds, tid, lane, wave); if (hn) cur = nxt; }
            GlaARaw ca; if (U < 1536) ca = gla_a_load(U - 512, PROJp, args.in[3], args.in[4], lane, wave);
            for (; U < 1536; U += WG) { GlaARaw na; const bool hn = U + WG < 1536; if (hn) na = gla_a_load(U + WG - 512, PROJp, args.in[3], args.in[4], lane, wave);
                gla_a_unit(U - 512, ca, PROJp, args.in[3], args.in[4], (float*)(ws + WS_KV), (float*)(ws + WS_DECAY), (float*)(ws + WS_BLG), lds, tid, lane, wave); if (hn) ca = na; }
        }
    }
    SEAM(PH_GLA_A); TSTAMP(PH_GLA_A);
    if (IN(PH_SCAN)) {
        for (int id = (tid >> 8) * (WG * 256) + wi * 256 + (tid & 255); id < 65536; id += WG * 512) gla_scan(id, (const float*)(ws + WS_KV), (const float*)(ws + WS_DECAY), (bf16*)(ws + WS_SPREV));
    }
    SEAM(PH_SCAN); TSTAMP(PH_SCAN);
    if (IN(PH_GLA_C)) {
        int U = wi; GlaCRaw cur; if (U < 1024) cur = gla_c_load(U, (const bf16*)(ws + WS_PROJ), (const float*)(ws + WS_BLG), (const bf16*)(ws + WS_SPREV), tid, lane, wave);
        for (; U < 1024; U += WG) { GlaCRaw nxt; const bool hn = U + WG < 1024; if (hn) nxt = gla_c_load(U + WG, (const bf16*)(ws + WS_PROJ), (const float*)(ws + WS_BLG), (const bf16*)(ws + WS_SPREV), tid, lane, wave);
            gla_c_unit(U, cur, args.in[5], (bf16*)(ws + WS_CAT), lds, tid, lane, wave); if (hn) cur = nxt; }
    }
    }
    SEAM(PH_GLA_C); TSTAMP(PH_GLA_C);
    if (IN(PH_OUTPROJ)) {
        pg8::Gemm g{(const bf16*)(ws + WS_CAT), (const bf16*)(ws + WS_WOUT), D};
        GridOrder S{D / 256, (T / 256) * (D / 256), G, vcu};
        pg8::EpiOut<0> E{(bf16*)(ws + WS_ATT), D, nullptr, 0, 1.f, 1.f};
        pg8::gemm_phase<pg8::EpiOut<0>, GridOrder, false, false>(lds, g, S, E);
    }
    SEAM(PH_OUTPROJ); TSTAMP(PH_OUTPROJ);
    int* cntg = (int*)ctl + CW_CNT; int* tokl = (int*)(ws + WS_TOKL);
    int* sel_e = (int*)(ws + WS_SEL); float* sel_gate = (float*)(ws + WS_SEL + 256 * 1024); int* sel_pos = (int*)(ws + WS_SEL + 512 * 1024);
    if (IN(PH_ROUTER)) {
        for (int blk = vcu; blk < T / 64; blk += G)
            router_block(blk, args.in[0], (bf16*)(ws + WS_ATT), args.in[9], (const bf16*)(ws + WS_WRH), (const bf16*)(ws + WS_WRL), args.in[11], (bf16*)(ws + WS_HN), (float*)(ws + WS_RSTD),
                         cntg, tokl, sel_e, sel_gate, sel_pos,
                         lds, tid, lane, wave);
    }
    SEAM(PH_ROUTER); TSTAMP(PH_ROUTER);
    LAS int* tab = (LAS int*)(lds + TAB_OFF);
    if (IN(PH_MOE1)) {
        if (wave == 0) { int mycnt; const int ts = lane_tstart(cntg, lane, mycnt); if (lane < NE) { tab[lane] = ts; tab[33 + lane] = mycnt; } if (lane == NE - 1) tab[32] = ts + ((mycnt + 255) >> 8); }
        __syncthreads();
        LAS int* rowtab = (LAS int*)(lds + ROWS_OFF);
        MoeOrder S{tab, rowtab, 8, tab[32], G, vcu};
        LAS int* uinfo = (LAS int*)(lds + TAB_OFF + 288);
        if (tid < ROWTABS) { int R, pn; int base = -1, nval = 0;
            if (S.map(tid, R, pn)) { const int e = MoeOrder::expert_of(tab, R), rt = R - tab[e]; base = e * T + rt * 256; nval = tab[33 + e] - rt * 256; }
            uinfo[tid * 3] = base; uinfo[tid * 3 + 1] = nval; }
        __syncthreads();
        { int tk[(ROWTABS * 256 + 511) / 512];
#pragma unroll
          for (int k = 0; k < (ROWTABS * 256 + 511) / 512; ++k) { const int idx = tid + 512 * k, j = idx >> 8, r = idx & 255; const int base = uinfo[j * 3], nval = uinfo[j * 3 + 1];
              tk[k] = (base >= 0) ? tokl[base + (r < nval ? r : 0)] : -1; }
#pragma unroll
          for (int k = 0; k < (ROWTABS * 256 + 511) / 512; ++k) { const int idx = tid + 512 * k;
              if (tk[k] >= 0) { rowtab[idx] = tk[k]; ((LAS float*)(lds + RSTD_OFF))[idx] = ((const float*)(ws + WS_RSTD))[tk[k]]; } } }
        __syncthreads();
        pg8::Gemm g{(const bf16*)(ws + WS_HN), (const bf16*)(ws + WS_WGL), MOE_FP8 ? D / 2 : D};
        pg8::EpiSwiglu E{(bf16*)(ws + WS_HID), args.in[13], args.in[15], (const LAS float*)(lds + RSTD_OFF), MOE_FP8 ? 1.f / (FP8_SA * FP8_SW) : 1.f, MOE_FP8, FP8_SH, 0};
        pg8::gemm_phase<pg8::EpiSwiglu, MoeOrder, true, true, MOE_FP8 != 0>(lds, g, S, E);
    }
    SEAM(PH_MOE1); TSTAMP(PH_MOE1);
    if (IN(PH_MOE2)) {
        if (wave == 0) { int mycnt; const int ts = lane_tstart(cntg, lane, mycnt); if (lane < NE) { tab[lane] = ts; tab[33 + lane] = mycnt; } if (lane == NE - 1) tab[32] = ts + ((mycnt + 255) >> 8); }
        __syncthreads();
        LAS int* rowtab = (LAS int*)(lds + ROWS_OFF);
        MoeOrder S{tab, rowtab, 4, tab[32], G, vcu};
        for (int j = 0; j < ROWTABS; ++j) { int R, pn; if (!S.map(j, R, pn)) break; if (tid < 256) rowtab[j * 256 + tid] = R * 256 + tid; }
        __syncthreads();
        pg8::Gemm g{(const bf16*)(ws + WS_HID), (const bf16*)(ws + WS_WD), MOE_FP8 ? D / 2 : D};
        pg8::EpiOut<1> E{(bf16*)(ws + WS_Y), D, args.in[17], D, 1.f / (FP8_SH * FP8_SW), FP8_SY};
        pg8::gemm_phase<pg8::EpiOut<1>, MoeOrder, true, true, true>(lds, g, S, E);
    }
    SEAM(PH_MOE2); TSTAMP(PH_MOE2);
    if (IN(PH_COMBINE)) {
        combine_rows((const bf16*)(ws + WS_ATT), args.out, (const unsigned char*)(ws + WS_Y), cntg, sel_e, sel_gate, sel_pos, args.in[18], gw, NGW, lane);
    }
#ifdef TPROBE
    TSTAMP(PH_COMBINE);
    if (blockIdx.x == 0 && tid == 0) { const unsigned long long dt = (tp_[TPROBE + 1] - tp_[TPROBE]) * 9ull, t0 = __builtin_amdgcn_s_memrealtime(); while (__builtin_amdgcn_s_memrealtime() - t0 < dt) __builtin_amdgcn_s_sleep(8); }
#endif
#undef IN
#undef SEAM
}
extern "C" void kernel_launch(void* const* d_in, const int* in_sizes, int n_in, void* d_out, int out_size, void* d_ws, size_t ws_size, hipStream_t stream) {
    static int grid = 0;
    if (grid == 0) {
        if (n_in != 19 || out_size != T * D || ws_size < WS_END) { fprintf(stderr, "kernel_launch: unexpected shapes (n_in %d out %d ws %zu)\n", n_in, out_size, ws_size); grid = -1; return; }
        int dev = 0, cus = 0, per_cu = 0;
        if (hipGetDevice(&dev) != hipSuccess || hipDeviceGetAttribute(&cus, hipDeviceAttributeMultiprocessorCount, dev) != hipSuccess) { grid = -1; return; }
        if (hipFuncSetAttribute((const void*)mk_fwd, hipFuncAttributeMaxDynamicSharedMemorySize, LDS_BYTES) != hipSuccess) { fprintf(stderr, "kernel_launch: hipFuncSetAttribute failed\n"); grid = -1; return; }
        if (hipOccupancyMaxActiveBlocksPerMultiprocessor(&per_cu, (const void*)mk_fwd, NWAVES * 64, LDS_BYTES) != hipSuccess || per_cu < 1) fprintf(stderr, "kernel_launch: occupancy query says %d\n", per_cu);
        (void)hipGetLastError();
        grid = cus;
    }
    if (grid < 0) return;
    (void)hipMemsetAsync((unsigned char*)d_ws + WS_CTL, 0, CTL_ZERO_BYTES, stream);
    Args a{};
    for (int i = 0; i < 19; ++i) a.in[i] = (const float*)d_in[i];
    a.out = (float*)d_out; a.ws = (unsigned char*)d_ws; a.ph_lo = 0; a.ph_hi = PH_N; a.li = 0;
    hipLaunchKernelGGL(mk_fwd, dim3(grid), dim3(NWAVES * 64), LDS_BYTES, stream, a);
}
```
